# Optimizing an MI355X kernel written in HIP

```python
import jax, jax.numpy as jnp
from jax import lax
import numpy as np

D_MODEL = 1024
BATCH = 8
SEQ = 2048
DEPTH = 1

MIX_WIDTH = D_MODEL
CONV_WIDTH = MIX_WIDTH // 2
ATTN_WIDTH = MIX_WIDTH - CONV_WIDTH
HEAD_DIM = 64
N_HEADS = ATTN_WIDTH // HEAD_DIM
CONV_K = 3
DILATED_PATTERNS = ((128, 1), (512, 4), (2048, 16))
ROPE_THETA = 500000.0
ROT_DIM = HEAD_DIM // 4
N_EXPERTS = 16
CAPACITY_FACTOR = 2
D_FF_EXPERT = 2 * D_MODEL
PROJ_WIDTH = 3 * CONV_WIDTH + 3 * ATTN_WIDTH
RMS_EPS = 1e-6
NEG_INF = -1e30

kernel_name = "hybrid_conv_dilated_attn_ec_moe_encoder"


def rmsnorm(x, g):
    xf = x.astype(jnp.float32)
    y = xf * lax.rsqrt(jnp.mean(xf * xf, axis=-1, keepdims=True) + RMS_EPS)
    return (y * g.astype(jnp.float32)).astype(x.dtype)


def partial_rope(t, positions):
    half = ROT_DIM // 2
    inv_freq = ROPE_THETA ** (-jnp.arange(half, dtype=jnp.float32) / half)
    ang = positions.astype(jnp.float32)[..., None] * inv_freq
    cos = jnp.cos(ang)[:, :, None, :]
    sin = jnp.sin(ang)[:, :, None, :]
    tf = t.astype(jnp.float32)
    t1, t2, rest = tf[..., :half], tf[..., half:ROT_DIM], tf[..., ROT_DIM:]
    out = jnp.concatenate([t1 * cos - t2 * sin, t2 * cos + t1 * sin, rest], axis=-1)
    return out.astype(t.dtype)


def centred_depthwise_conv(u, w):
    s = u.shape[1]
    up = jnp.pad(u, ((0, 0), (1, 1), (0, 0)))
    return w[0] * up[:, 0:s] + w[1] * up[:, 1:s + 1] + w[2] * up[:, 2:s + 2]


def dilated_band_attention(q, k, v, window, dil):
    b, s, h, dh = q.shape
    half = (window // 2) // dil
    blk = half
    L = s // dil
    nb = -(-L // blk)
    lp = nb * blk

    def to_sub(t):
        return t.reshape(b, L, dil, h, dh).transpose(0, 2, 3, 1, 4)

    qs = jnp.pad(to_sub(q), ((0, 0), (0, 0), (0, 0), (0, lp - L), (0, 0)))
    qs = qs.reshape(b, dil, h, nb, blk, dh)

    def key_blocks(t):
        tp = jnp.pad(to_sub(t), ((0, 0), (0, 0), (0, 0), (blk, lp - L + blk), (0, 0)))
        tp = tp.reshape(b, dil, h, nb + 2, blk, dh)
        return jnp.concatenate([tp[:, :, :, :nb], tp[:, :, :, 1:nb + 1], tp[:, :, :, 2:]], axis=-2)

    kb, vb = key_blocks(k), key_blocks(v)
    qpos = np.arange(nb)[:, None, None] * blk + np.arange(blk)[None, :, None]
    kpos = (np.arange(nb)[:, None, None] - 1) * blk + np.arange(3 * blk)[None, None, :]
    mask = (np.abs(qpos - kpos) <= half) & (kpos >= 0) & (kpos < L)

    sc = jnp.einsum('brhnqc,brhnkc->brhnqk', qs.astype(jnp.float32), kb.astype(jnp.float32))
    sc = jnp.where(mask, sc, NEG_INF)
    m = jnp.max(sc, axis=-1)
    p = jnp.where(mask, jnp.exp(sc - m[..., None]), 0.0)
    l = jnp.sum(p, axis=-1)
    num = jnp.einsum('brhnqk,brhnkc->brhnqc', p, vb.astype(jnp.float32))

    def from_sub(t):
        t = t.reshape((b, dil, h, lp) + t.shape[5:])[:, :, :, :L]
        t = jnp.moveaxis(t, 3, 1)
        return t.reshape((b, s, h) + t.shape[4:])

    return from_sub(num), from_sub(m), from_sub(l)


def mixed_dilated_attention(q, k, v):
    nums, ms, ls = [], [], []
    for window, dil in DILATED_PATTERNS:
        n_, m_, l_ = dilated_band_attention(q, k, v, window, dil)
        nums.append(n_); ms.append(m_); ls.append(l_)
    m_all = jnp.stack(ms)
    a = jnp.exp(m_all - jnp.max(m_all, axis=0, keepdims=True))
    den = jnp.sum(a * jnp.stack(ls), axis=0)
    num = jnp.sum(a[..., None] * jnp.stack(nums), axis=0)
    return (num / den[..., None]).astype(q.dtype)


def expert_choice_ffn(h, w_router, w_gate, w_up, w_down):
    b, s, d = h.shape
    cap = CAPACITY_FACTOR * s // N_EXPERTS
    logits = jnp.einsum('bsd,de->bse', h.astype(jnp.float32), w_router.astype(jnp.float32))
    aff = jax.nn.softmax(logits, axis=-1)
    gates, idx = lax.top_k(jnp.swapaxes(aff, 1, 2), cap)
    bidx = jnp.arange(b)[:, None, None]
    xe = h[bidx, idx]
    a = jnp.einsum('becd,edf->becf', xe, w_gate)
    u = jnp.einsum('becd,edf->becf', xe, w_up)
    y = jnp.einsum('becf,efd->becd', jax.nn.silu(a) * u, w_down)
    y = y * gates[..., None].astype(y.dtype)
    return jnp.zeros_like(h).at[bidx, idx].add(y)


def setup_inputs(seed: int = 0) -> dict:
    key = jax.random.key(seed)
    ks = jax.random.split(key, 16)
    f32 = jnp.float32
    nrm = lambda k, shape, fan: jax.random.normal(k, shape, f32) * (fan ** -0.5)
    gain = lambda k, shape: 1.0 + 0.02 * jax.random.normal(k, shape, f32)
    x = jax.random.normal(ks[0], (BATCH, SEQ, D_MODEL), f32)
    offsets = jax.random.randint(ks[1], (BATCH, 1), 0, 4096, dtype=jnp.int32)
    positions = offsets + jnp.arange(SEQ, dtype=jnp.int32)[None, :]
    return {
        "x": x,
        "positions": positions,
        "g_mix": gain(ks[2], (DEPTH, D_MODEL)),
        "w_in": nrm(ks[3], (DEPTH, D_MODEL, PROJ_WIDTH), D_MODEL),
        "conv_w": nrm(ks[4], (DEPTH, CONV_K, CONV_WIDTH), CONV_K),
        "g_conv_out": gain(ks[5], (DEPTH, CONV_WIDTH)),
        "g_attn_out": gain(ks[6], (DEPTH, ATTN_WIDTH)),
        "w_out": nrm(ks[7], (DEPTH, MIX_WIDTH, D_MODEL), MIX_WIDTH),
        "g_ffn": gain(ks[8], (DEPTH, D_MODEL)),
        "w_router": nrm(ks[9], (DEPTH, D_MODEL, N_EXPERTS), D_MODEL),
        "w_gate": nrm(ks[10], (DEPTH, N_EXPERTS, D_MODEL, D_FF_EXPERT), D_MODEL),
        "w_up": nrm(ks[11], (DEPTH, N_EXPERTS, D_MODEL, D_FF_EXPERT), D_MODEL),
        "w_down": nrm(ks[12], (DEPTH, N_EXPERTS, D_FF_EXPERT, D_MODEL), D_FF_EXPERT),
        "g_final": gain(ks[13], (D_MODEL,)),
    }


def reference(x, positions, g_mix, w_in, conv_w, g_conv_out, g_attn_out, w_out,
              g_ffn, w_router, w_gate, w_up, w_down, g_final):
    b, s, _ = x.shape
    splits = np.cumsum([CONV_WIDTH] * 3 + [ATTN_WIDTH] * 2).tolist()
    for layer in range(DEPTH):
        h = rmsnorm(x, g_mix[layer])
        p = jnp.einsum('bsd,dp->bsp', h, w_in[layer])
        c_b, c_c, c_u, q, k, v = jnp.split(p, splits, axis=-1)
        y_conv = c_b * centred_depthwise_conv(c_c * c_u, conv_w[layer])
        q = partial_rope(q.reshape(b, s, N_HEADS, HEAD_DIM), positions) * (HEAD_DIM ** -0.5)
        k = partial_rope(k.reshape(b, s, N_HEADS, HEAD_DIM), positions)
        v = v.reshape(b, s, N_HEADS, HEAD_DIM)
        y_attn = mixed_dilated_attention(q, k, v).reshape(b, s, ATTN_WIDTH)
        y = jnp.concatenate([rmsnorm(y_conv, g_conv_out[layer]),
                             rmsnorm(y_attn, g_attn_out[layer])], axis=-1)
        x = x + jnp.einsum('bsm,md->bsd', y, w_out[layer])
        h2 = rmsnorm(x, g_ffn[layer])
        x = x + expert_choice_ffn(h2, w_router[layer], w_gate[layer], w_up[layer], w_down[layer])
    return rmsnorm(x, g_final)
```

```cpp
#include <hip/hip_runtime.h>
#include <cstdio>
#include <cstdint>

#define GAS __attribute__((address_space(1)))
#define LAS __attribute__((address_space(3)))
typedef unsigned short bf16_t;
typedef short bf16x8 __attribute__((ext_vector_type(8)));
typedef float f32x4 __attribute__((ext_vector_type(4)));
typedef float f32x2 __attribute__((ext_vector_type(2)));
typedef float f32x16 __attribute__((ext_vector_type(16)));
typedef unsigned u32x4 __attribute__((ext_vector_type(4)));
typedef unsigned u32x2 __attribute__((ext_vector_type(2)));
typedef __bf16 bf16x2_t __attribute__((ext_vector_type(2)));

#ifndef MK_N_LAUNCHES
#define MK_N_LAUNCHES 10
#endif

constexpr int BATCH = 8, SEQ = 2048, DM = 1024, M = BATCH * SEQ, PW = 3072, NH = 8, HD = 64, NE = 16, CAP = 256, DFF = 2048;
constexpr int NWAVES = 8, NTHREADS = 512;
constexpr float RMS_EPS = 1e-6f;
constexpr float QSCALE = 0.125f * 1.4426950408889634f;
constexpr int N_PHASES = 10;

constexpr size_t MiB = 1u << 20;
constexpr size_t WS_CTL = 0, CTL_ZERO_BYTES = 1 * MiB;
constexpr size_t WS_RSTD2 = 1 * MiB;
constexpr size_t WS_ROPE = 2 * MiB;
constexpr size_t WS_AFF = 3 * MiB;
constexpr size_t WS_AROWS = 4 * MiB;
constexpr size_t WS_GATEV = 4 * MiB + 256 * 1024;
constexpr size_t WS_INV = 5 * MiB;
constexpr size_t WS_WIN = 8 * MiB;
constexpr size_t WS_WOUT = 14 * MiB;
constexpr size_t WS_WGU = 16 * MiB;
constexpr size_t WS_WD = 144 * MiB;
constexpr size_t WS_XN = 208 * MiB;
constexpr size_t WS_Y = 240 * MiB;
constexpr size_t WS_CN = 208 * MiB;
constexpr size_t WS_PB = 272 * MiB;
constexpr size_t WS_OP = 368 * MiB;
constexpr size_t WS_ML = 416 * MiB;
constexpr size_t WS_H = 272 * MiB;
constexpr size_t WS_END = 420 * MiB;
constexpr int CW_BAR = 4096;

constexpr int RING_BYTES = 131072;
constexpr int LDSCTL_OFF = RING_BYTES, MISC_OFF = LDSCTL_OFF + 320;
constexpr int LDS_BYTES = 147456;

#define LDS_WAIT() asm volatile("s_waitcnt lgkmcnt(0)" ::: "memory")
#define VM_WAIT() asm volatile("s_waitcnt vmcnt(0)" ::: "memory")
#define RLX_AGENT __ATOMIC_RELAXED, __HIP_MEMORY_SCOPE_AGENT
__device__ __forceinline__ unsigned cvtpk(float lo, float hi) { f32x2 v = {lo, hi}; bf16x2_t b = __builtin_convertvector(v, bf16x2_t); return __builtin_bit_cast(unsigned, b); }
__device__ __forceinline__ float bf_lo(unsigned w) { return __builtin_bit_cast(float, w << 16); }
__device__ __forceinline__ float bf_hi(unsigned w) { return __builtin_bit_cast(float, w & 0xffff0000u); }
__device__ __forceinline__ float wave_sum(float v) {
#pragma unroll
    for (int o = 1; o < 64; o <<= 1) v += __shfl_xor(v, o);
    return v;
}

#define XB_TMO      128
#define XB_XCNT(j)  (256  + 64 * (j))
#define XB_XSUB(j)  (1280 + 64 * (j))
#define XB_XGEN(j)  (2304 + 64 * (j))
#define XB_TOP      3328
#define XB_TOPGEN   3392
#define XCD_BAR_WORDS 3456
#define XB_SPIN_CAP (1u << 18)
__device__ __forceinline__ unsigned xb_ld(unsigned* p)              { return __hip_atomic_load(p, __ATOMIC_RELAXED, __HIP_MEMORY_SCOPE_AGENT); }
__device__ __forceinline__ unsigned xb_add(unsigned* p, unsigned v) { return __hip_atomic_fetch_add(p, v, __ATOMIC_RELAXED, __HIP_MEMORY_SCOPE_AGENT); }
__device__ __forceinline__ unsigned xb_xcc_id() { return (unsigned)__builtin_amdgcn_s_getreg((3 << 11) | 20) & 0xFu; }
#define XB_SPIN(cond, bar) do { unsigned _sp = 0; while (cond) { __builtin_amdgcn_s_sleep(1); \
    if ((++_sp & 255u) == 0u) { if (xb_ld(&(bar)[XB_TMO])) break; if (_sp > XB_SPIN_CAP) { atomicAdd(&(bar)[XB_TMO], 1u); break; } } } } while (0)
struct XcdBarrier { unsigned* bar; unsigned x; volatile LAS unsigned* st; };
__device__ __forceinline__ XcdBarrier xcd_barrier_post(unsigned* bar, volatile LAS unsigned* st) {
    XcdBarrier b; b.bar = bar; b.x = xb_xcc_id(); b.st = st;
    if (threadIdx.x == 0) (void)xb_add(&bar[XB_XCNT(b.x)], 1u);
    return b;
}
__device__ __forceinline__ void xcd_barrier_complete(unsigned* bar, unsigned x, unsigned& nloc, unsigned& nx) {
    const unsigned G = gridDim.x * gridDim.y * gridDim.z;
    unsigned sum, cnt, mine, sp = 0u;
    for (;;) {
        sum = 0u; cnt = 0u; mine = 0u;
#pragma unroll
        for (unsigned j = 0; j < 16; ++j) { const unsigned c = xb_ld(&bar[XB_XCNT(j)]); sum += c; cnt += (c > 0u) ? 1u : 0u; mine = (j == x) ? c : mine; }
        if (sum == G) break;
        __builtin_amdgcn_s_sleep(1);
        if ((++sp & 255u) == 0u) { if (xb_ld(&bar[XB_TMO])) break; if (sp > XB_SPIN_CAP) { atomicAdd(&bar[XB_TMO], 1u); break; } }
    }
    nloc = mine > 0u ? mine : 1u; nx = cnt > 0u ? cnt : 1u;
}
__device__ __forceinline__ void xcd_barrier(const XcdBarrier& b) {
    asm volatile("s_waitcnt vmcnt(0)" ::: "memory");
    __syncthreads();
    if (threadIdx.x == 0) {
        unsigned* bar = b.bar;
        __builtin_amdgcn_s_waitcnt(0);
        unsigned nloc = b.st[0], nx = b.st[1];
        if (nloc == 0u) { xcd_barrier_complete(bar, b.x, nloc, nx); b.st[0] = nloc; b.st[1] = nx; }
        const unsigned old = xb_add(&bar[XB_XSUB(b.x)], 1u);
        const unsigned gen = old / nloc;
        if (old + 1u == (gen + 1u) * nloc) {
            __builtin_amdgcn_fence(__ATOMIC_RELEASE, "agent");
            asm volatile("s_waitcnt vmcnt(0)" ::: "memory");
            const unsigned og = xb_add(&bar[XB_TOP], 1u);
            const unsigned tg = og / nx;
            if (og + 1u == (tg + 1u) * nx) xb_add(&bar[XB_TOPGEN], 1u);
            else XB_SPIN(xb_ld(&bar[XB_TOPGEN]) == tg, bar);
            __builtin_amdgcn_fence(__ATOMIC_ACQUIRE, "agent");
            xb_add(&bar[XB_XGEN(b.x)], 1u);
            asm volatile("s_waitcnt vmcnt(0)" ::: "memory");
        } else {
            XB_SPIN(xb_ld(&bar[XB_XGEN(b.x)]) == gen, bar);
            __builtin_amdgcn_fence(__ATOMIC_ACQUIRE, "agent");
            asm volatile("s_waitcnt vmcnt(0)" ::: "memory");
        }
    }
    __syncthreads();
}

struct Frame {
    LAS unsigned char* lds;
    int tid, lane, wave, vcu, G;
    const float* x; const int* pos; const float *g_mix, *w_in, *conv_w, *g_conv, *g_attn, *w_out, *g_ffn, *w_router, *w_gate, *w_up, *w_down, *g_final;
    float* out; unsigned char* ws;
};

struct Unit { int pm, pb, pc; };
struct Gemm { const bf16_t* A; const bf16_t* Bt; const int* arows; int K; };

struct DenseOrder {
    int nM, nN, nwg, G, c;
    __device__ void init(int Mr, int N, int G_, int c_) { nM = Mr / 256; nN = N / 256; nwg = nM * nN; G = G_; c = c_; }
    __device__ bool next(int i, Unit& u) const {
        const long L = (long)i * G + c; if (L >= nwg) return false;
        int wgid = (int)L; { const int q = nwg / 8, r = nwg % 8, xcd = wgid % 8, off = wgid / 8; wgid = (xcd < r ? xcd * (q + 1) : r * (q + 1) + (xcd - r) * q) + off; }
        const int nig = 8 * nN, gid = wgid / nig, fm = gid * 8, gsz = (nM - fm) < 8 ? (nM - fm) : 8;
        u.pm = fm + ((wgid % nig) % gsz); u.pb = (wgid % nig) / gsz; u.pc = u.pb; return true;
    }
};
struct ExpertOrder {
    int NB, nunits, G, c;
    __device__ void init(int NB_, int G_, int c_) { NB = NB_; nunits = NE * NB_ * BATCH; G = G_; c = c_; }
    __device__ bool next(int i, Unit& u) const {
        int uid;
        if ((G & 7) == 0) uid = (i * 8 + (c & 7)) * (G >> 3) + (c >> 3); else uid = i * G + c;
        if (uid >= nunits) return false;
        const int b = uid & 7, q = uid >> 3, n = q % NB, e = q / NB;
        u.pm = e * 8 + b; u.pb = e * NB + n; u.pc = n; return true;
    }
};

__device__ __forceinline__ int perm32(int rho) { const int n = rho >> 4, i = rho & 15; return 8 * (i >> 2) + 4 * n + (i & 3); }

template <class Epi, class Sched>
__device__ __forceinline__ void gemm_phase_simple(const Gemm g, const Sched& S, const Epi& E) {
    const int tid = threadIdx.x, wid = __builtin_amdgcn_readfirstlane(tid >> 6), lane = tid & 63, wr = wid >> 2, wc = wid & 3, fr = lane & 15, fq = lane >> 4;
    const int K = g.K;
    Unit u;
    for (int ui = 0; S.next(ui, u); ++ui) {
        f32x4 acc[2][2][4][2];
#pragma unroll
        for (int a = 0; a < 2; ++a)
#pragma unroll
            for (int b = 0; b < 2; ++b)
#pragma unroll
                for (int m = 0; m < 4; ++m)
#pragma unroll
                    for (int n = 0; n < 2; ++n) acc[a][b][m][n] = (f32x4){0.f, 0.f, 0.f, 0.f};
        unsigned aoff[2][4], boff[2][2];
#pragma unroll
        for (int ai = 0; ai < 2; ++ai)
#pragma unroll
            for (int m = 0; m < 4; ++m) { const int r = u.pm * 256 + ai * 128 + wr * 64 + m * 16 + fr; const int row = g.arows ? g.arows[r] : r; aoff[ai][m] = (unsigned)row * (unsigned)K + 8u * fq; }
#pragma unroll
        for (int bj = 0; bj < 2; ++bj)
#pragma unroll
            for (int n = 0; n < 2; ++n) { const int row = u.pb * 256 + bj * 128 + wc * 32 + perm32(16 * n + fr); boff[bj][n] = (unsigned)row * (unsigned)K + 8u * fq; }
        for (int k0 = 0; k0 < K; k0 += 32) {
            bf16x8 At[2][4], Bt[2][2];
#pragma unroll
            for (int ai = 0; ai < 2; ++ai)
#pragma unroll
                for (int m = 0; m < 4; ++m) At[ai][m] = *(const bf16x8*)(g.A + (size_t)aoff[ai][m] + k0);
#pragma unroll
            for (int bj = 0; bj < 2; ++bj)
#pragma unroll
                for (int n = 0; n < 2; ++n) Bt[bj][n] = *(const bf16x8*)(g.Bt + (size_t)boff[bj][n] + k0);
#pragma unroll
            for (int ai = 0; ai < 2; ++ai)
#pragma unroll
                for (int bj = 0; bj < 2; ++bj)
#pragma unroll
                    for (int m = 0; m < 4; ++m)
#pragma unroll
                        for (int n = 0; n < 2; ++n) acc[ai][bj][m][n] = __builtin_amdgcn_mfma_f32_16x16x32_bf16(Bt[bj][n], At[ai][m], acc[ai][bj][m][n], 0, 0, 0);
        }
        E(acc, u, wr, wc, fr, fq);
    }
}

__device__ __forceinline__ u32x4 pack8(const f32x4& v0, const f32x4& v1) { u32x4 w; w.x = cvtpk(v0[0], v0[1]); w.y = cvtpk(v0[2], v0[3]); w.z = cvtpk(v1[0], v1[1]); w.w = cvtpk(v1[2], v1[3]); return w; }

struct EpiQKV {
    bf16_t* PB; const float* rope;
    __device__ __forceinline__ void operator()(const f32x4 (&acc)[2][2][4][2], const Unit& u, int wr, int wc, int fr, int fq) const {
        const int ct = u.pc * 256, region = ct / 512;
        const bool ropew = (region == 3 || region == 4) && ((wc & 1) == 0);
        const float qs = (region == 3) ? QSCALE : 1.0f;
        const float sgn = (fq == 0) ? -1.0f : 1.0f;
#pragma unroll
        for (int ai = 0; ai < 2; ++ai)
#pragma unroll
            for (int m = 0; m < 4; ++m) {
                const int r = u.pm * 256 + ai * 128 + wr * 64 + m * 16 + fr;
                f32x4 cs[4];
                if (ropew) {
#pragma unroll
                    for (int i = 0; i < 4; ++i) cs[i] = *(const f32x4*)(rope + (size_t)r * 16 + 4 * i);
                }
#pragma unroll
                for (int bj = 0; bj < 2; ++bj) {
                    f32x4 v0 = acc[ai][bj][m][0], v1 = acc[ai][bj][m][1];
                    if (ropew) {
                        f32x4 p0, p1;
#pragma unroll
                        for (int j = 0; j < 4; ++j) { p0[j] = __shfl_xor(v0[j], 16); p1[j] = __shfl_xor(v1[j], 16); }
                        if (fq < 2) {
                            v0[0] = v0[0] * cs[0][0] + sgn * p0[0] * cs[0][1]; v0[1] = v0[1] * cs[0][2] + sgn * p0[1] * cs[0][3];
                            v0[2] = v0[2] * cs[1][0] + sgn * p0[2] * cs[1][1]; v0[3] = v0[3] * cs[1][2] + sgn * p0[3] * cs[1][3];
                            v1[0] = v1[0] * cs[2][0] + sgn * p1[0] * cs[2][1]; v1[1] = v1[1] * cs[2][2] + sgn * p1[1] * cs[2][3];
                            v1[2] = v1[2] * cs[3][0] + sgn * p1[2] * cs[3][1]; v1[3] = v1[3] * cs[3][2] + sgn * p1[3] * cs[3][3];
                        }
                    }
                    v0 = v0 * qs; v1 = v1 * qs;
                    *(u32x4*)(PB + (size_t)r * PW + ct + bj * 128 + wc * 32 + 8 * fq) = pack8(v0, v1);
                }
            }
    }
};
struct EpiRes {
    const float* x; float* out; bf16_t* XN2;
    __device__ __forceinline__ void operator()(const f32x4 (&acc)[2][2][4][2], const Unit& u, int wr, int wc, int fr, int fq) const {
#pragma unroll
        for (int ai = 0; ai < 2; ++ai)
#pragma unroll
            for (int m = 0; m < 4; ++m) {
                const int r = u.pm * 256 + ai * 128 + wr * 64 + m * 16 + fr;
#pragma unroll
                for (int bj = 0; bj < 2; ++bj) {
                    const size_t off = (size_t)r * DM + u.pc * 256 + bj * 128 + wc * 32 + 8 * fq;
                    const f32x4 v0 = acc[ai][bj][m][0] + *(const f32x4*)(x + off), v1 = acc[ai][bj][m][1] + *(const f32x4*)(x + off + 4);
                    *(f32x4*)(out + off) = v0; *(f32x4*)(out + off + 4) = v1;
                    *(u32x4*)(XN2 + off) = pack8(v0, v1);
                }
            }
    }
};
struct EpiSwiGLU {
    bf16_t* H; const float* rstd2; const int* arows;
    __device__ __forceinline__ void operator()(const f32x4 (&acc)[2][2][4][2], const Unit& u, int wr, int wc, int fr, int fq) const {
#pragma unroll
        for (int ai = 0; ai < 2; ++ai)
#pragma unroll
            for (int m = 0; m < 4; ++m) {
                const int r = u.pm * 256 + ai * 128 + wr * 64 + m * 16 + fr;
                const float rs = rstd2[arows[r]];
                f32x4 h[2];
#pragma unroll
                for (int n = 0; n < 2; ++n)
#pragma unroll
                    for (int j = 0; j < 4; ++j) {
                        const float gv = acc[ai][0][m][n][j] * rs, uv = acc[ai][1][m][n][j] * rs;
                        const float sg = __builtin_amdgcn_rcpf(1.0f + __builtin_amdgcn_exp2f(-1.4426950408889634f * gv));
                        h[n][j] = gv * sg * uv;
                    }
                *(u32x4*)(H + (size_t)r * DFF + u.pc * 128 + wc * 32 + 8 * fq) = pack8(h[0], h[1]);
            }
    }
};
struct EpiContrib {
    bf16_t* CN; const float* gatev;
    __device__ __forceinline__ void operator()(const f32x4 (&acc)[2][2][4][2], const Unit& u, int wr, int wc, int fr, int fq) const {
#pragma unroll
        for (int ai = 0; ai < 2; ++ai)
#pragma unroll
            for (int m = 0; m < 4; ++m) {
                const int r = u.pm * 256 + ai * 128 + wr * 64 + m * 16 + fr;
                const float gt = gatev[r];
#pragma unroll
                for (int bj = 0; bj < 2; ++bj)
                    *(u32x4*)(CN + (size_t)r * DM + u.pc * 256 + bj * 128 + wc * 32 + 8 * fq) = pack8(acc[ai][bj][m][0] * gt, acc[ai][bj][m][1] * gt);
            }
    }
};

__device__ __forceinline__ void transpose_item(const float* W, int ldn, const float* kscale, bf16_t* WT, int ldk, int k0, int n0, size_t dst_row0, LAS float* scr, int lane) {
#pragma unroll 8
    for (int i = 0; i < 32; ++i) { const int kk = 2 * i + (lane >> 5); float v = W[(size_t)(k0 + kk) * ldn + n0 + (lane & 31)]; if (kscale) v *= kscale[k0 + kk]; scr[kk * 33 + (lane & 31)] = v; }
    LDS_WAIT(); asm volatile("" ::: "memory");
    const int c = lane & 7;
#pragma unroll
    for (int j = 0; j < 4; ++j) { const int n = (lane >> 3) + 8 * j; const LAS float* s = scr + (8 * c) * 33 + n;
        u32x4 o; o.x = cvtpk(s[0 * 33], s[1 * 33]); o.y = cvtpk(s[2 * 33], s[3 * 33]); o.z = cvtpk(s[4 * 33], s[5 * 33]); o.w = cvtpk(s[6 * 33], s[7 * 33]);
        *(u32x4*)(WT + (dst_row0 + n) * (size_t)ldk + k0 + 8 * c) = o; }
    LDS_WAIT(); asm volatile("" ::: "memory");
}
__device__ __forceinline__ void p0_prologue(Frame& F) {
    LAS float* scr = (LAS float*)(F.lds + F.wave * 16384);
    const int gw = F.vcu * NWAVES + F.wave, NGW = F.G * NWAVES;
    bf16_t* Win_t = (bf16_t*)(F.ws + WS_WIN); bf16_t* Wout_t = (bf16_t*)(F.ws + WS_WOUT); bf16_t* Wgu_t = (bf16_t*)(F.ws + WS_WGU); bf16_t* Wd_t = (bf16_t*)(F.ws + WS_WD);
    constexpr int I_IN = 16 * 96, I_OUT = 16 * 32, I_G = 16 * 16 * 64, I_D = 16 * 32 * 32;
    constexpr int NITEMS = I_IN + I_OUT + 2 * I_G + I_D;
    for (int it = gw; it < NITEMS; it += NGW) {
        int r = it;
        if (r < I_IN) { const int kb = r / 96, nb = r % 96; transpose_item(F.w_in, PW, F.g_mix, Win_t, DM, 64 * kb, 32 * nb, 32 * nb, scr, F.lane); continue; } r -= I_IN;
        if (r < I_OUT) { const int kb = r / 32, nb = r % 32; const float* ks = (kb < 8) ? F.g_conv : (F.g_attn - 512); transpose_item(F.w_out, DM, ks, Wout_t, DM, 64 * kb, 32 * nb, 32 * nb, scr, F.lane); continue; } r -= I_OUT;
        if (r < 2 * I_G) { const int which = r / I_G; r %= I_G; const int e = r / 1024, q = r % 1024, kb = q / 64, nb = q % 64, n0 = 32 * nb;
            const float* W = (which ? F.w_up : F.w_gate) + (size_t)e * DM * DFF;
            transpose_item(W, DFF, F.g_ffn, Wgu_t + (size_t)e * 4096 * DM, DM, 64 * kb, n0, (size_t)(n0 / 128) * 256 + which * 128 + (n0 % 128), scr, F.lane); continue; } r -= 2 * I_G;
        { const int e = r / 1024, q = r % 1024, kb = q / 32, nb = q % 32;
            transpose_item(F.w_down + (size_t)e * DFF * DM, DM, nullptr, Wd_t + (size_t)e * DM * DFF, DFF, 64 * kb, 32 * nb, 32 * nb, scr, F.lane); }
    }
    bf16_t* XN = (bf16_t*)(F.ws + WS_XN);
    for (int m = gw; m < M; m += NGW) {
        const f32x4* xr = (const f32x4*)(F.x + (size_t)m * DM) + F.lane;
        f32x4 v[4]; float s = 0.f;
#pragma unroll
        for (int j = 0; j < 4; ++j) { v[j] = xr[64 * j]; s += (v[j].x * v[j].x + v[j].y * v[j].y) + (v[j].z * v[j].z + v[j].w * v[j].w); }
        const float rstd = 1.0f / sqrtf(wave_sum(s) * (1.f / DM) + RMS_EPS);
        u32x2* o = (u32x2*)(XN + (size_t)m * DM) + F.lane;
#pragma unroll
        for (int j = 0; j < 4; ++j) { u32x2 w; w.x = cvtpk(v[j].x * rstd, v[j].y * rstd); w.y = cvtpk(v[j].z * rstd, v[j].w * rstd); o[64 * j] = w; }
    }
    float* rope = (float*)(F.ws + WS_ROPE);
    for (int i = (F.vcu * NTHREADS + F.tid); i < M * 8; i += F.G * NTHREADS) {
        const int tok = i >> 3, f = i & 7;
        const double inv = exp2(-(double)f * 0.125 * 18.931568569324174);
        const double ang = (double)F.pos[tok] * inv;
        rope[2 * i] = (float)cos(ang); rope[2 * i + 1] = (float)sin(ang);
    }
}

__device__ __forceinline__ int crow(int r, int hi) { return (r & 3) + 8 * (r >> 2) + 4 * hi; }
__device__ __forceinline__ void p2a_attention(Frame& F) {
    const bf16_t* PB = (const bf16_t*)(F.ws + WS_PB);
    bf16_t* OP = (bf16_t*)(F.ws + WS_OP); float* ML = (float*)(F.ws + WS_ML);
    const int gw = F.vcu * NWAVES + F.wave, NGW = F.G * NWAVES;
    constexpr int NTASK = BATCH * NH * 3 * 64;
    const int per = (NTASK + NGW - 1) / NGW;
    const int lane = F.lane, r32 = lane & 31, hi = lane >> 5;
    for (int T = gw * per; T < (gw + 1) * per && T < NTASK; ++T) {
        const int bh = T / 192, w = T % 192, pi = w / 64, a = w % 64;
        const int b = bh >> 3, h = bh & 7;
        const int dl = (pi == 0) ? 1 : (pi == 1 ? 4 : 16);
        const int L = SEQ / dl, tpc = L / 32, rc = a / tpc, ta = a % tpc;
        const size_t rowb = (size_t)b * SEQ;
        const int qpos = (32 * ta + r32) * dl + rc;
        const bf16_t* qp = PB + (rowb + qpos) * PW + 1536 + h * 64 + hi * 8;
        bf16x8 qr[4];
#pragma unroll
        for (int d0 = 0; d0 < 4; ++d0) qr[d0] = *(const bf16x8*)(qp + d0 * 16);
        float mrun = -1e30f, lrun = 0.f;
        f32x16 o0 = {}, o1 = {};
        for (int kt = ta - 2; kt <= ta + 2; ++kt) {
            if (kt < 0 || kt >= tpc) continue;
            const int kpos = (32 * kt + r32) * dl + rc;
            const bf16_t* kp = PB + (rowb + kpos) * PW + 2048 + h * 64 + hi * 8;
            bf16x8 kf[4];
#pragma unroll
            for (int d0 = 0; d0 < 4; ++d0) kf[d0] = *(const bf16x8*)(kp + d0 * 16);
            f32x16 p = {};
#pragma unroll
            for (int d0 = 0; d0 < 4; ++d0) p = __builtin_amdgcn_mfma_f32_32x32x16_bf16(kf[d0], qr[d0], p, 0, 0, 0);
            if (kt != ta) {
                const int lq = 32 * ta + r32;
#pragma unroll
                for (int r = 0; r < 16; ++r) { const int lk = 32 * kt + crow(r, hi); const int dd = lq - lk; if (dd > 64 || dd < -64) p[r] = -1e30f; }
            }
            float mx = p[0];
#pragma unroll
            for (int r = 1; r < 16; ++r) mx = fmaxf(mx, p[r]);
            mx = fmaxf(mx, __shfl_xor(mx, 32));
            const float mnew = fmaxf(mrun, mx);
            const float alpha = __builtin_amdgcn_exp2f(mrun - mnew);
            float rs = 0.f;
#pragma unroll
            for (int r = 0; r < 16; ++r) { p[r] = __builtin_amdgcn_exp2f(p[r] - mnew); rs += p[r]; }
            lrun = lrun * alpha + rs; mrun = mnew;
#pragma unroll
            for (int r = 0; r < 16; ++r) { o0[r] *= alpha; o1[r] *= alpha; }
            bf16x8 pf[2];
#pragma unroll
            for (int s = 0; s < 2; ++s) { u32x4 w; w.x = cvtpk(p[8 * s + 0], p[8 * s + 1]); w.y = cvtpk(p[8 * s + 2], p[8 * s + 3]); w.z = cvtpk(p[8 * s + 4], p[8 * s + 5]); w.w = cvtpk(p[8 * s + 6], p[8 * s + 7]); pf[s] = __builtin_bit_cast(bf16x8, w); }
            const bf16_t* vb = PB + rowb * PW + 2560 + h * 64 + r32;
#pragma unroll
            for (int s = 0; s < 2; ++s) {
                bf16x8 va0, va1;
#pragma unroll
                for (int j = 0; j < 8; ++j) {
                    const int lk = 32 * kt + 16 * s + 8 * (j >> 2) + 4 * hi + (j & 3);
                    const bf16_t* vp = vb + (size_t)(lk * dl + rc) * PW;
                    va0[j] = (short)vp[0]; va1[j] = (short)vp[32];
                }
                o0 = __builtin_amdgcn_mfma_f32_32x32x16_bf16(va0, pf[s], o0, 0, 0, 0);
                o1 = __builtin_amdgcn_mfma_f32_32x32x16_bf16(va1, pf[s], o1, 0, 0, 0);
            }
        }
        const float ltot = lrun + __shfl_xor(lrun, 32);
        const float il = 1.0f / ltot;
        const size_t tok = rowb + qpos;
        bf16_t* op = OP + ((size_t)pi * M + tok) * 512 + h * 64;
#pragma unroll
        for (int g4 = 0; g4 < 4; ++g4) {
            u32x2 w0, w1;
            w0.x = cvtpk(o0[4 * g4 + 0] * il, o0[4 * g4 + 1] * il); w0.y = cvtpk(o0[4 * g4 + 2] * il, o0[4 * g4 + 3] * il);
            w1.x = cvtpk(o1[4 * g4 + 0] * il, o1[4 * g4 + 1] * il); w1.y = cvtpk(o1[4 * g4 + 2] * il, o1[4 * g4 + 3] * il);
            *(u32x2*)(op + 8 * g4 + 4 * hi) = w0; *(u32x2*)(op + 32 + 8 * g4 + 4 * hi) = w1;
        }
        if (hi == 0) { f32x2 ml = {mrun, ltot}; *(f32x2*)(ML + (((size_t)pi * M + tok) * 8 + h) * 2) = ml; }
    }
}

__device__ __forceinline__ void p2b_combine(Frame& F) {
    const bf16_t* PB = (const bf16_t*)(F.ws + WS_PB);
    const bf16_t* OP = (const bf16_t*)(F.ws + WS_OP); const float* ML = (const float*)(F.ws + WS_ML);
    bf16_t* Y = (bf16_t*)(F.ws + WS_Y);
    const int gw = F.vcu * NWAVES + F.wave, NGW = F.G * NWAVES, lane = F.lane;
    float cw[3][8];
#pragma unroll
    for (int t = 0; t < 3; ++t)
#pragma unroll
        for (int j = 0; j < 8; ++j) cw[t][j] = F.conv_w[t * 512 + 8 * lane + j];
    const int per = (M + NGW - 1) / NGW;
    for (int tok = gw * per; tok < (gw + 1) * per && tok < M; ++tok) {
        const int s = tok & (SEQ - 1);
        const int hh = lane >> 3;
        float mp[3], lp[3];
#pragma unroll
        for (int p = 0; p < 3; ++p) { const f32x2 ml = *(const f32x2*)(ML + (((size_t)p * M + tok) * 8 + hh) * 2); mp[p] = ml.x; lp[p] = ml.y; }
        const float mm = fmaxf(fmaxf(mp[0], mp[1]), mp[2]);
        float wp[3], den = 0.f;
#pragma unroll
        for (int p = 0; p < 3; ++p) { wp[p] = __builtin_amdgcn_exp2f(mp[p] - mm) * lp[p]; den += wp[p]; }
        const float iden = 1.0f / den;
        float ya[8];
#pragma unroll
        for (int j = 0; j < 8; ++j) ya[j] = 0.f;
#pragma unroll
        for (int p = 0; p < 3; ++p) {
            const u32x4 w = *(const u32x4*)(OP + ((size_t)p * M + tok) * 512 + 8 * lane);
            const float c = wp[p] * iden;
            ya[0] += c * bf_lo(w.x); ya[1] += c * bf_hi(w.x); ya[2] += c * bf_lo(w.y); ya[3] += c * bf_hi(w.y);
            ya[4] += c * bf_lo(w.z); ya[5] += c * bf_hi(w.z); ya[6] += c * bf_lo(w.w); ya[7] += c * bf_hi(w.w);
        }
        float ssa = 0.f;
#pragma unroll
        for (int j = 0; j < 8; ++j) ssa += ya[j] * ya[j];
        const bf16_t* prow = PB + (size_t)tok * PW + 8 * lane;
        float uu[3][8];
#pragma unroll
        for (int t = 0; t < 3; ++t) {
            const int ss = s + t - 1;
            if (ss >= 0 && ss < SEQ) {
                const u32x4 c4 = *(const u32x4*)(prow + (ptrdiff_t)(t - 1) * PW + 512), u4 = *(const u32x4*)(prow + (ptrdiff_t)(t - 1) * PW + 1024);
                uu[t][0] = bf_lo(c4.x) * bf_lo(u4.x); uu[t][1] = bf_hi(c4.x) * bf_hi(u4.x); uu[t][2] = bf_lo(c4.y) * bf_lo(u4.y); uu[t][3] = bf_hi(c4.y) * bf_hi(u4.y);
                uu[t][4] = bf_lo(c4.z) * bf_lo(u4.z); uu[t][5] = bf_hi(c4.z) * bf_hi(u4.z); uu[t][6] = bf_lo(c4.w) * bf_lo(u4.w); uu[t][7] = bf_hi(c4.w) * bf_hi(u4.w);
            } else {
#pragma unroll
                for (int j = 0; j < 8; ++j) uu[t][j] = 0.f;
            }
        }
        const u32x4 b4 = *(const u32x4*)(prow);
        float cb[8] = {bf_lo(b4.x), bf_hi(b4.x), bf_lo(b4.y), bf_hi(b4.y), bf_lo(b4.z), bf_hi(b4.z), bf_lo(b4.w), bf_hi(b4.w)};
        float yc[8]; float ssc = 0.f;
#pragma unroll
        for (int j = 0; j < 8; ++j) { yc[j] = cb[j] * (cw[0][j] * uu[0][j] + cw[1][j] * uu[1][j] + cw[2][j] * uu[2][j]); ssc += yc[j] * yc[j]; }
        const float ra = 1.0f / sqrtf(wave_sum(ssa) * (1.f / 512) + RMS_EPS), rc = 1.0f / sqrtf(wave_sum(ssc) * (1.f / 512) + RMS_EPS);
        u32x4 wa, wc4;
        wa.x = cvtpk(ya[0] * ra, ya[1] * ra); wa.y = cvtpk(ya[2] * ra, ya[3] * ra); wa.z = cvtpk(ya[4] * ra, ya[5] * ra); wa.w = cvtpk(ya[6] * ra, ya[7] * ra);
        wc4.x = cvtpk(yc[0] * rc, yc[1] * rc); wc4.y = cvtpk(yc[2] * rc, yc[3] * rc); wc4.z = cvtpk(yc[4] * rc, yc[5] * rc); wc4.w = cvtpk(yc[6] * rc, yc[7] * rc);
        *(u32x4*)(Y + (size_t)tok * DM + 8 * lane) = wc4;
        *(u32x4*)(Y + (size_t)tok * DM + 512 + 8 * lane) = wa;
    }
}

__device__ __forceinline__ void p3b_router(Frame& F) {
    LAS float* gw_l = (LAS float*)F.lds;
    for (int i = F.tid; i < DM * NE; i += NTHREADS) gw_l[i] = F.g_ffn[i >> 4] * F.w_router[i];
    __syncthreads();
    float* rstd2 = (float*)(F.ws + WS_RSTD2); float* aff = (float*)(F.ws + WS_AFF); int* inv = (int*)(F.ws + WS_INV);
    const int gw = F.vcu * NWAVES + F.wave, NGW = F.G * NWAVES, lane = F.lane;
    const int per = (M + NGW - 1) / NGW;
    for (int tok = gw * per; tok < (gw + 1) * per && tok < M; ++tok) {
        const f32x4* xr = (const f32x4*)(F.out + (size_t)tok * DM) + lane;
        float lg[16];
#pragma unroll
        for (int e = 0; e < 16; ++e) lg[e] = 0.f;
        float ss = 0.f;
#pragma unroll 1
        for (int j = 0; j < 4; ++j) {
            const f32x4 v = xr[64 * j];
            ss += (v.x * v.x + v.y * v.y) + (v.z * v.z + v.w * v.w);
#pragma unroll
            for (int c = 0; c < 4; ++c) {
                const LAS f32x4* wrow = (const LAS f32x4*)(gw_l + (256 * j + 4 * lane + c) * 16);
#pragma unroll
                for (int q = 0; q < 4; ++q) { const f32x4 w = wrow[q]; lg[4 * q + 0] += v[c] * w.x; lg[4 * q + 1] += v[c] * w.y; lg[4 * q + 2] += v[c] * w.z; lg[4 * q + 3] += v[c] * w.w; }
            }
        }
        const float rstd = 1.0f / sqrtf(wave_sum(ss) * (1.f / DM) + RMS_EPS);
        float mx = -1e30f;
#pragma unroll
        for (int e = 0; e < 16; ++e) { lg[e] = wave_sum(lg[e]) * rstd; mx = fmaxf(mx, lg[e]); }
        float den = 0.f;
#pragma unroll
        for (int e = 0; e < 16; ++e) { lg[e] = expf(lg[e] - mx); den += lg[e]; }
        float mine = 0.f;
#pragma unroll
        for (int e = 0; e < 16; ++e) if (lane == e) mine = lg[e] / den;
        const int b = tok / SEQ, s = tok % SEQ;
        if (lane < 16) { aff[((size_t)b * NE + lane) * SEQ + s] = mine; inv[(size_t)tok * 16 + lane] = -1; }
        if (lane == 0) rstd2[tok] = rstd;
    }
    __syncthreads();
}

__device__ __forceinline__ void p4_topk(Frame& F) {
    const float* aff = (const float*)(F.ws + WS_AFF); int* arows = (int*)(F.ws + WS_AROWS); float* gatev = (float*)(F.ws + WS_GATEV); int* inv = (int*)(F.ws + WS_INV);
    if (F.wave != 0) return;
    const int lane = F.lane;
    for (int task = F.vcu; task < BATCH * NE; task += F.G) {
        const int b = task / NE, e = task % NE, pm = e * 8 + b;
        unsigned v[32];
#pragma unroll
        for (int i = 0; i < 32; ++i) v[i] = __builtin_bit_cast(unsigned, aff[(size_t)task * SEQ + i * 64 + lane]);
        unsigned T = 0u;
        for (int bit = 30; bit >= 0; --bit) {
            const unsigned cand = T | (1u << bit);
            int cnt = 0;
#pragma unroll
            for (int i = 0; i < 32; ++i) cnt += __builtin_popcountll(__ballot(v[i] >= cand));
            if (cnt >= CAP) T = cand;
        }
        int cgt = 0;
#pragma unroll
        for (int i = 0; i < 32; ++i) cgt += __builtin_popcountll(__ballot(v[i] > T));
        const int need = CAP - cgt;
        const unsigned long long lt = (1ull << lane) - 1ull;
        int base = 0, eqbase = 0;
#pragma unroll
        for (int i = 0; i < 32; ++i) {
            const bool eq = (v[i] == T);
            const unsigned long long meq = __ballot(eq);
            const int req = eqbase + __builtin_popcountll(meq & lt);
            const bool sel = (v[i] > T) || (eq && req < need);
            const unsigned long long ms = __ballot(sel);
            const int slot = base + __builtin_popcountll(ms & lt);
            if (sel) {
                const int s = i * 64 + lane;
                arows[pm * 256 + slot] = b * SEQ + s;
                gatev[pm * 256 + slot] = __builtin_bit_cast(float, v[i]);
                inv[(size_t)(b * SEQ + s) * 16 + e] = slot;
            }
            base += __builtin_popcountll(ms); eqbase += __builtin_popcountll(meq);
        }
    }
}

__device__ __forceinline__ void p7_final(Frame& F) {
    const bf16_t* CN = (const bf16_t*)(F.ws + WS_CN); const int* inv = (const int*)(F.ws + WS_INV);
    const int gw = F.vcu * NWAVES + F.wave, NGW = F.G * NWAVES, lane = F.lane;
    f32x4 gf[4];
#pragma unroll
    for (int j = 0; j < 4; ++j) gf[j] = ((const f32x4*)F.g_final)[64 * j + lane];
    const int per = (M + NGW - 1) / NGW;
    for (int tok = gw * per; tok < (gw + 1) * per && tok < M; ++tok) {
        f32x4* xr = (f32x4*)(F.out + (size_t)tok * DM) + lane;
        f32x4 v[4];
#pragma unroll
        for (int j = 0; j < 4; ++j) v[j] = xr[64 * j];
        const int b = tok / SEQ;
        const int myinv = (lane < 16) ? inv[(size_t)tok * 16 + lane] : -1;
        for (int e = 0; e < 16; ++e) {
            const int sl = __shfl(myinv, e);
            if (sl >= 0) {
                const u32x2* cr = (const u32x2*)(CN + ((size_t)(e * 8 + b) * 256 + sl) * DM) + lane;
#pragma unroll
                for (int j = 0; j < 4; ++j) { const u32x2 w = cr[64 * j]; v[j].x += bf_lo(w.x); v[j].y += bf_hi(w.x); v[j].z += bf_lo(w.y); v[j].w += bf_hi(w.y); }
            }
        }
        float ss = 0.f;
#pragma unroll
        for (int j = 0; j < 4; ++j) ss += (v[j].x * v[j].x + v[j].y * v[j].y) + (v[j].z * v[j].z + v[j].w * v[j].w);
        const float rstd = 1.0f / sqrtf(wave_sum(ss) * (1.f / DM) + RMS_EPS);
#pragma unroll
        for (int j = 0; j < 4; ++j) xr[64 * j] = v[j] * rstd * gf[j];
    }
}

struct Args { const void* in[14]; float* out; unsigned char* ws; int ph_lo, ph_hi; };
__global__ void __launch_bounds__(NTHREADS, 2) fwd_kernel(Args args) {
    extern __shared__ __attribute__((aligned(16))) unsigned char lds[];
    Frame F;
    F.lds = (LAS unsigned char*)lds;
    F.tid = threadIdx.x; F.lane = F.tid & 63; F.wave = __builtin_amdgcn_readfirstlane(F.tid >> 6);
    F.G = gridDim.x; { const int bx = blockIdx.x; F.vcu = (F.G % 8 == 0) ? (bx % 8) * (F.G / 8) + bx / 8 : bx; }
    F.x = (const float*)args.in[0]; F.pos = (const int*)args.in[1]; F.g_mix = (const float*)args.in[2]; F.w_in = (const float*)args.in[3];
    F.conv_w = (const float*)args.in[4]; F.g_conv = (const float*)args.in[5]; F.g_attn = (const float*)args.in[6]; F.w_out = (const float*)args.in[7];
    F.g_ffn = (const float*)args.in[8]; F.w_router = (const float*)args.in[9]; F.w_gate = (const float*)args.in[10]; F.w_up = (const float*)args.in[11];
    F.w_down = (const float*)args.in[12]; F.g_final = (const float*)args.in[13];
    F.out = args.out; F.ws = args.ws;
    volatile LAS unsigned* MISC = (volatile LAS unsigned*)(F.lds + MISC_OFF);
    for (int u = F.tid; u < (LDS_BYTES - LDSCTL_OFF) / 4; u += NTHREADS) ((LAS unsigned*)(F.lds + LDSCTL_OFF))[u] = 0u;
    __syncthreads();
    const int lo = args.ph_lo, hi = args.ph_hi;
    XcdBarrier bar; bar.bar = (unsigned*)(F.ws + WS_CTL) + CW_BAR; bar.x = 0; bar.st = nullptr;
    if (hi - lo > 1) bar = xcd_barrier_post((unsigned*)(F.ws + WS_CTL) + CW_BAR, MISC + 8);
#ifndef PH_MASK
#define PH_MASK 0x3ff
#endif
#define IN(k) (((PH_MASK >> (k)) & 1) && lo <= (k) && (k) < hi)
#define SEAM(k) do { if (IN(k) && IN((k) + 1)) xcd_barrier(bar); } while (0)
    bf16_t* XN = (bf16_t*)(F.ws + WS_XN);
    if (IN(0)) { p0_prologue(F); SEAM(0); }
    if (IN(1)) {
        Gemm g{XN, (const bf16_t*)(F.ws + WS_WIN), nullptr, DM}; DenseOrder S; S.init(M, PW, F.G, (int)blockIdx.x);
        EpiQKV E{(bf16_t*)(F.ws + WS_PB), (const float*)(F.ws + WS_ROPE)};
        gemm_phase_simple(g, S, E); SEAM(1);
    }
    if (IN(2)) { p2a_attention(F); SEAM(2); }
    if (IN(3)) { p2b_combine(F); SEAM(3); }
    if (IN(4)) {
        Gemm g{(const bf16_t*)(F.ws + WS_Y), (const bf16_t*)(F.ws + WS_WOUT), nullptr, DM}; DenseOrder S; S.init(M, DM, F.G, (int)blockIdx.x);
        EpiRes E{F.x, F.out, XN};
        gemm_phase_simple(g, S, E); SEAM(4);
    }
    if (IN(5)) { p3b_router(F); SEAM(5); }
    if (IN(6)) { p4_topk(F); SEAM(6); }
    if (IN(7)) {
        Gemm g{XN, (const bf16_t*)(F.ws + WS_WGU), (const int*)(F.ws + WS_AROWS), DM}; ExpertOrder S; S.init(16, F.G, (int)blockIdx.x);
        EpiSwiGLU E{(bf16_t*)(F.ws + WS_H), (const float*)(F.ws + WS_RSTD2), (const int*)(F.ws + WS_AROWS)};
        gemm_phase_simple(g, S, E); SEAM(7);
    }
    if (IN(8)) {
        Gemm g{(const bf16_t*)(F.ws + WS_H), (const bf16_t*)(F.ws + WS_WD), nullptr, DFF}; ExpertOrder S; S.init(4, F.G, (int)blockIdx.x);
        EpiContrib E{(bf16_t*)(F.ws + WS_CN), (const float*)(F.ws + WS_GATEV)};
        gemm_phase_simple(g, S, E); SEAM(8);
    }
    if (IN(9)) { p7_final(F); }
#undef IN
#undef SEAM
}

extern "C" void kernel_launch(void* const* d_in, const int* in_sizes, int n_in, void* d_out, int out_size, void* d_ws, size_t ws_size, hipStream_t stream) {
    static int grid = 0;
    if (grid == 0) {
        if (n_in != 14 || out_size != M * DM || ws_size < WS_END) { fprintf(stderr, "kernel_launch: unexpected problem (n_in %d out %d ws %zu)\n", n_in, out_size, ws_size); grid = -1; return; }
        int dev = 0, cus = 0, per_cu = 0;
        if (hipGetDevice(&dev) != hipSuccess || hipDeviceGetAttribute(&cus, hipDeviceAttributeMultiprocessorCount, dev) != hipSuccess) { grid = -1; return; }
        if (hipFuncSetAttribute((const void*)fwd_kernel, hipFuncAttributeMaxDynamicSharedMemorySize, LDS_BYTES) != hipSuccess) { fprintf(stderr, "kernel_launch: hipFuncSetAttribute failed\n"); grid = -1; return; }
        if (hipOccupancyMaxActiveBlocksPerMultiprocessor(&per_cu, (const void*)fwd_kernel, NTHREADS, LDS_BYTES) != hipSuccess || per_cu < 1) { fprintf(stderr, "kernel_launch: occupancy query says %d\n", per_cu); per_cu = 1; }
        (void)hipGetLastError();
        grid = cus;
    }
    if (grid < 0) return;
    (void)hipMemsetAsync((char*)d_ws + WS_CTL, 0, CTL_ZERO_BYTES, stream);
    Args a{};
    for (int i = 0; i < 14; ++i) a.in[i] = d_in[i];
    a.out = (float*)d_out; a.ws = (unsigned char*)d_ws;
    if (MK_N_LAUNCHES == 1) {
        a.ph_lo = 0; a.ph_hi = N_PHASES;
        hipLaunchKernelGGL(fwd_kernel, dim3(grid), dim3(NTHREADS), LDS_BYTES, stream, a);
    } else {
        for (int p = 0; p < N_PHASES; ++p) { a.ph_lo = p; a.ph_hi = p + 1; hipLaunchKernelGGL(fwd_kernel, dim3(grid), dim3(NTHREADS), LDS_BYTES, stream, a); }
    }
}
```

```cpp
#include <hip/hip_runtime.h>
#include <cstdio>
#include <cstdint>

#define GAS __attribute__((address_space(1)))
#define LAS __attribute__((address_space(3)))
typedef unsigned short bf16_t;
typedef short bf16x8 __attribute__((ext_vector_type(8)));
typedef float f32x4 __attribute__((ext_vector_type(4)));
typedef float f32x2 __attribute__((ext_vector_type(2)));
typedef float f32x16 __attribute__((ext_vector_type(16)));
typedef unsigned u32x4 __attribute__((ext_vector_type(4)));
typedef unsigned u32x2 __attribute__((ext_vector_type(2)));
typedef __bf16 bf16x2_t __attribute__((ext_vector_type(2)));
typedef int v4i_t __attribute__((ext_vector_type(4)));
typedef int v8i_t __attribute__((ext_vector_type(8)));

#ifndef NG1
#define NG1 192
#endif
#ifndef N1_ITEMS
#define N1_ITEMS 11000
#endif
#ifndef ATT_WAVES
#define ATT_WAVES 6
#endif
#ifndef N5_ITEMS
#define N5_ITEMS 4000
#endif
#ifndef N6_ITEMS
#define N6_ITEMS 1500
#endif
#ifndef OVERLAP_CONV
#define OVERLAP_CONV 1
#endif
#ifndef EXP_FP8
#define EXP_FP8 1
#endif
#ifndef MK_N_LAUNCHES
#define MK_N_LAUNCHES 1
#endif

constexpr int BATCH = 8, SEQ = 2048, DM = 1024, M = BATCH * SEQ, PW = 3072, NH = 8, HD = 64, NE = 16, CAP = 256, DFF = 2048;
constexpr int NWAVES = 8, NTHREADS = 512;
constexpr float RMS_EPS = 1e-6f;
constexpr float QSCALE = 0.125f * 1.4426950408889634f;
constexpr int N_PHASES = 10;

constexpr size_t MiB = 1u << 20;
constexpr size_t WS_CTL = 0, CTL_ZERO_BYTES = 64 * 1024;
constexpr size_t WS_RSTD2 = 1 * MiB;
constexpr size_t WS_IRSTD1 = 1 * MiB + 512 * 1024;
constexpr size_t WS_XN2 = 336 * MiB;
constexpr size_t WS_ROPE = 2 * MiB;
constexpr size_t WS_AFF = 3 * MiB;
constexpr size_t WS_AROWS = 4 * MiB;
constexpr size_t WS_GATEV = 4 * MiB + 256 * 1024;
constexpr size_t WS_RSG = 4 * MiB + 512 * 1024;
constexpr size_t WS_INV = 5 * MiB;
constexpr size_t WS_WIN = 8 * MiB;
constexpr size_t WS_WOUT = 14 * MiB;
constexpr size_t WS_WGU = 16 * MiB;
constexpr size_t WS_WD = 144 * MiB;
constexpr size_t WS_XN = 208 * MiB;
constexpr size_t WS_Y = 240 * MiB;
constexpr size_t WS_CN = 208 * MiB;
constexpr size_t WS_PB = 272 * MiB;
constexpr size_t WS_QH = 320 * MiB, WS_KH = 336 * MiB, WS_VH = 352 * MiB;
constexpr int PBW = 1024;
constexpr size_t WS_OP = 368 * MiB;
constexpr size_t WS_ML = 416 * MiB;
constexpr size_t WS_H = 272 * MiB;
constexpr size_t WS_X1 = 384 * MiB;
constexpr size_t WS_END = 420 * MiB;
constexpr int CW_BAR = 4096;

constexpr int RING_BYTES = 131072;
constexpr int LDSCTL_OFF = RING_BYTES, MISC_OFF = LDSCTL_OFF + 320;
constexpr int LDS_BYTES = 147456;
constexpr int AROWS_LDS_OFF = MISC_OFF + 128;

#define LDS_WAIT() asm volatile("s_waitcnt lgkmcnt(0)" ::: "memory")
#define VM_WAIT() asm volatile("s_waitcnt vmcnt(0)" ::: "memory")
#define RLX_AGENT __ATOMIC_RELAXED, __HIP_MEMORY_SCOPE_AGENT
__device__ __forceinline__ unsigned cvtpk(float lo, float hi) { f32x2 v = {lo, hi}; bf16x2_t b = __builtin_convertvector(v, bf16x2_t); return __builtin_bit_cast(unsigned, b); }
__device__ __forceinline__ unsigned cvt4_fp8(float a, float b, float c, float d) { int w = 0; w = __builtin_amdgcn_cvt_pk_fp8_f32(a, b, w, false); w = __builtin_amdgcn_cvt_pk_fp8_f32(c, d, w, true); return (unsigned)w; }
__device__ __forceinline__ v8i_t cat8(bf16x8 a, bf16x8 b) { const v4i_t x = __builtin_bit_cast(v4i_t, a), y = __builtin_bit_cast(v4i_t, b); return __builtin_shufflevector(x, y, 0, 1, 2, 3, 4, 5, 6, 7); }
constexpr float W8_SCALE = 32.0f, W8_INV = 1.0f / 32.0f;
constexpr float CN_SCALE = 16.0f, CN_INV = 1.0f / 16.0f;
__device__ __forceinline__ float bf_lo(unsigned w) { return __builtin_bit_cast(float, w << 16); }
__device__ __forceinline__ float bf_hi(unsigned w) { return __builtin_bit_cast(float, w & 0xffff0000u); }
__device__ __forceinline__ float wave_sum(float v) {
#pragma unroll
    for (int o = 1; o < 64; o <<= 1) v += __shfl_xor(v, o);
    return v;
}

#define XB_TMO      128
#define XB_XCNT(j)  (256  + 64 * (j))
#define XB_XSUB(j)  (1280 + 64 * (j))
#define XB_XGEN(j)  (2304 + 64 * (j))
#define XB_TOP      3328
#define XB_TOPGEN   3392
#define XCD_BAR_WORDS 3456
#define XB_SPIN_CAP (1u << 18)
__device__ __forceinline__ unsigned xb_ld(unsigned* p)              { return __hip_atomic_load(p, __ATOMIC_RELAXED, __HIP_MEMORY_SCOPE_AGENT); }
__device__ __forceinline__ unsigned xb_add(unsigned* p, unsigned v) { return __hip_atomic_fetch_add(p, v, __ATOMIC_RELAXED, __HIP_MEMORY_SCOPE_AGENT); }
__device__ __forceinline__ unsigned xb_xcc_id() { return (unsigned)__builtin_amdgcn_s_getreg((3 << 11) | 20) & 0xFu; }
#define XB_SPIN(cond, bar) do { unsigned _sp = 0; while (cond) { __builtin_amdgcn_s_sleep(1); \
    if ((++_sp & 255u) == 0u) { if (xb_ld(&(bar)[XB_TMO])) break; if (_sp > XB_SPIN_CAP) { atomicAdd(&(bar)[XB_TMO], 1u); break; } } } } while (0)
struct XcdBarrier { unsigned* bar; unsigned x; volatile LAS unsigned* st; };
__device__ __forceinline__ XcdBarrier xcd_barrier_post(unsigned* bar, volatile LAS unsigned* st) {
    XcdBarrier b; b.bar = bar; b.x = xb_xcc_id(); b.st = st;
    if (threadIdx.x == 0) (void)xb_add(&bar[XB_XCNT(b.x)], 1u);
    return b;
}
__device__ __forceinline__ void xcd_barrier_complete(unsigned* bar, unsigned x, unsigned& nloc, unsigned& nx) {
    const unsigned G = gridDim.x * gridDim.y * gridDim.z;
    unsigned sum, cnt, mine, sp = 0u;
    for (;;) {
        sum = 0u; cnt = 0u; mine = 0u;
#pragma unroll
        for (unsigned j = 0; j < 16; ++j) { const unsigned c = xb_ld(&bar[XB_XCNT(j)]); sum += c; cnt += (c > 0u) ? 1u : 0u; mine = (j == x) ? c : mine; }
        if (sum == G) break;
        __builtin_amdgcn_s_sleep(1);
        if ((++sp & 255u) == 0u) { if (xb_ld(&bar[XB_TMO])) break; if (sp > XB_SPIN_CAP) { atomicAdd(&bar[XB_TMO], 1u); break; } }
    }
    nloc = mine > 0u ? mine : 1u; nx = cnt > 0u ? cnt : 1u;
}
__device__ __forceinline__ void xcd_barrier(const XcdBarrier& b) {
    asm volatile("s_waitcnt vmcnt(0)" ::: "memory");
    __syncthreads();
    if (threadIdx.x == 0) {
        unsigned* bar = b.bar;
        __builtin_amdgcn_s_waitcnt(0);
        unsigned nloc = b.st[0], nx = b.st[1];
        if (nloc == 0u) { xcd_barrier_complete(bar, b.x, nloc, nx); b.st[0] = nloc; b.st[1] = nx; }
        const unsigned old = xb_add(&bar[XB_XSUB(b.x)], 1u);
        const unsigned gen = old / nloc;
        if (old + 1u == (gen + 1u) * nloc) {
            __builtin_amdgcn_fence(__ATOMIC_RELEASE, "agent");
            asm volatile("s_waitcnt vmcnt(0)" ::: "memory");
            const unsigned og = xb_add(&bar[XB_TOP], 1u);
            const unsigned tg = og / nx;
            if (og + 1u == (tg + 1u) * nx) xb_add(&bar[XB_TOPGEN], 1u);
            else XB_SPIN(xb_ld(&bar[XB_TOPGEN]) == tg, bar);
            __builtin_amdgcn_fence(__ATOMIC_ACQUIRE, "agent");
            xb_add(&bar[XB_XGEN(b.x)], 1u);
            asm volatile("s_waitcnt vmcnt(0)" ::: "memory");
        } else {
            XB_SPIN(xb_ld(&bar[XB_XGEN(b.x)]) == gen, bar);
            __builtin_amdgcn_fence(__ATOMIC_ACQUIRE, "agent");
            asm volatile("s_waitcnt vmcnt(0)" ::: "memory");
        }
    }
    __syncthreads();
}

struct Frame {
    LAS unsigned char* lds;
    int tid, lane, wave, vcu, G;
    const float* x; const int* pos; const float *g_mix, *w_in, *conv_w, *g_conv, *g_attn, *w_out, *g_ffn, *w_router, *w_gate, *w_up, *w_down, *g_final;
    float* out; unsigned char* ws;
};

struct Unit { int pm, pb, pc; };
struct Gemm { const bf16_t* A; const bf16_t* Bt; const int* arows; int K; const LAS int* arows_l = nullptr; };

struct DenseOrder {
    int nM, nN, nwg, G, c;
    __device__ __forceinline__ void init(int Mr, int N, int G_, int c_) { nM = Mr / 256; nN = N / 256; nwg = nM * nN; G = G_; c = c_; }
    __device__ __forceinline__ bool next(int i, Unit& u) const {
        const long L = (long)i * G + c; if (L >= nwg) return false;
        int wgid = (int)L; { const int q = nwg / 8, r = nwg % 8, xcd = wgid % 8, off = wgid / 8; wgid = (xcd < r ? xcd * (q + 1) : r * (q + 1) + (xcd - r) * q) + off; }
        const int nig = 8 * nN, gid = wgid / nig, fm = gid * 8, gsz = (nM - fm) < 8 ? (nM - fm) : 8;
        u.pm = fm + ((wgid % nig) % gsz); u.pb = (wgid % nig) / gsz; u.pc = u.pb; return true;
    }
};
struct ExpertOrder {
    int NB, nunits, G, c;
    __device__ __forceinline__ void init(int NB_, int G_, int c_) { NB = NB_; nunits = NE * NB_ * BATCH; G = G_; c = c_; }
    __device__ __forceinline__ bool next(int i, Unit& u) const {
        int uid;
        if ((G & 7) == 0) uid = (i * 8 + (c & 7)) * (G >> 3) + (c >> 3); else uid = i * G + c;
        if (uid >= nunits) return false;
        const int b = uid & 7, q = uid >> 3, n = q % NB, e = q / NB;
        u.pm = e * 8 + b; u.pb = e * NB + n; u.pc = n; return true;
    }
};

__device__ __forceinline__ int perm32(int rho) { const int n = rho >> 4, i = rho & 15; return 8 * (i >> 2) + 4 * n + (i & 3); }

constexpr int BK = 64, HTB = 128 * BK * 2;
__host__ __device__ __forceinline__ int lds_byte(int r, int c) { const int st = (r >> 4) * 2 + (c >> 5), rr = r & 15, cc = c & 31, ob = rr * 64 + cc * 2; return st * 1024 + (ob ^ (((ob >> 9) & 1) << 5)); }
__host__ __device__ __forceinline__ void stage_rc(int b, int& R, int& C) { const int st = b / 1024, sb = b % 1024, swz = sb ^ (((sb >> 9) & 1) << 5); R = (st >> 1) * 16 + swz / 64; C = (st & 1) * 32 + (swz % 64) / 2; }

__device__ __forceinline__ void mfma8_inplace(f32x4& c, const v8i_t a, const v8i_t b, const int one8) {
    asm volatile("v_mfma_scale_f32_16x16x128_f8f6f4 %0, %1, %2, %0, %3, %3 op_sel_hi:[0,0,0]" : "+v"(c) : "v"(a), "v"(b), "v"(one8));
}
template <bool F8, class Epi, class Sched>
__device__ __forceinline__ void gemm_phase_fast(LAS unsigned char* lds, const Gemm g, const Sched& S, const Epi& E) {
    const int tid = threadIdx.x, wid = __builtin_amdgcn_readfirstlane(tid >> 6), lane = tid & 63, wr = wid >> 2, wc = wid & 3, fr = lane & 15, fq = lane >> 4;
    const int K = g.K, nt = K / BK;
    int RA[2], CA[2]; unsigned voffB[2];
#pragma unroll
    for (int i = 0; i < 2; ++i) { int R, C; stage_rc(tid * 16 + i * 8192, R, C); RA[i] = R; CA[i] = C; const int Rb = (R & ~31) + perm32(R & 31); voffB[i] = (unsigned)(Rb * K + C) * 2u; }
    const size_t kstep = (size_t)(BK * 2);
    const size_t hstep = (size_t)128 * K * 2;
    const size_t tstep = 2 * hstep;
    const unsigned ldsw = (unsigned)wid * 1024u;
    const int aoff = lds_byte(wr * 64 + fr, fq * 8), boff = lds_byte(wc * 32 + fr, fq * 8);
#define PG8_SA(b, h) (((b) * 2 + (h)) * HTB)
#define PG8_SB(b, h) ((4 + (b) * 2 + (h)) * HTB)
#define PG8_STAGE(bufoff, gbase, voff) do { _Pragma("unroll") for (int _i = 0; _i < 2; ++_i) \
        __builtin_amdgcn_global_load_lds((const unsigned*)((const char*)(gbase) + (voff)[_i]), (LAS unsigned*)(lds + (bufoff) + ldsw + _i * 8192), 16, 0, 0); } while (0)
#define PG8_LDA(dst, b, h) do { _Pragma("unroll") for (int m = 0; m < 4; ++m) _Pragma("unroll") for (int k = 0; k < 2; ++k) dst[m][k] = *(const LAS bf16x8*)(lds + PG8_SA(b, h) + aoff + m * 2048 + k * 1024); } while (0)
#define PG8_LDB(dst, b, h) do { _Pragma("unroll") for (int n = 0; n < 2; ++n) _Pragma("unroll") for (int k = 0; k < 2; ++k) dst[n][k] = *(const LAS bf16x8*)(lds + PG8_SB(b, h) + boff + n * 2048 + k * 1024); } while (0)
#define PG8_MMA(ai, bj, At, Bt) do { __builtin_amdgcn_s_setprio(1); _Pragma("unroll") for (int m = 0; m < 4; ++m) _Pragma("unroll") for (int n = 0; n < 2; ++n) { \
        if constexpr (F8) mfma8_inplace(acc[ai][bj][m][n], cat8(Bt[n][0], Bt[n][1]), cat8(At[m][0], At[m][1]), one8); \
        else { _Pragma("unroll") for (int k = 0; k < 2; ++k) acc[ai][bj][m][n] = __builtin_amdgcn_mfma_f32_16x16x32_bf16(Bt[n][k], At[m][k], acc[ai][bj][m][n], 0, 0, 0); } } \
        __builtin_amdgcn_s_setprio(0); } while (0)
#define PG8_WAIT_V(n) asm volatile("s_waitcnt vmcnt(" #n ")" ::: "memory")
#define PG8_WAIT_L(n) asm volatile("s_waitcnt lgkmcnt(" #n ")" ::: "memory")
#define PG8_BAR __builtin_amdgcn_s_barrier()
#define PG8_SCHED __builtin_amdgcn_sched_barrier(0)
#define PG8_AOFFS(dst, u, uidx) do { _Pragma("unroll") for (int _h = 0; _h < 2; ++_h) _Pragma("unroll") for (int _i = 0; _i < 2; ++_i) { const int _r = (u).pm * 256 + _h * 128 + RA[_i]; \
        const int _row = g.arows_l ? g.arows_l[(uidx) * 256 + _h * 128 + RA[_i]] : (g.arows ? g.arows[_r] : _r); dst[_h][_i] = ((unsigned)_row * (unsigned)K + (unsigned)CA[_i]) * 2u; } } while (0)
    Unit cur, nxt; int ui = 0;
    if (!S.next(0, cur)) return;
    int one8 = 0x7f7f7f7f; asm volatile("" : "+v"(one8));
    f32x4 acc[2][2][4][2];
#pragma unroll
    for (int a = 0; a < 2; ++a)
#pragma unroll
        for (int b = 0; b < 2; ++b)
#pragma unroll
            for (int m = 0; m < 4; ++m)
#pragma unroll
                for (int n = 0; n < 2; ++n) acc[a][b][m][n] = (f32x4){0.f, 0.f, 0.f, 0.f};
    bf16x8 At[4][2], B0[2][2], B1[2][2];
    unsigned vA[2][2], vN[2][2];
    PG8_AOFFS(vA, cur, 0);
    const char* const gA = (const char*)g.A;
    const char* cB = (const char*)g.Bt + (size_t)cur.pb * tstep;
    PG8_STAGE(PG8_SB(0, 0), cB, voffB); PG8_STAGE(PG8_SB(0, 1), cB + hstep, voffB); PG8_STAGE(PG8_SA(0, 0), gA, vA[0]); PG8_STAGE(PG8_SA(0, 1), gA, vA[1]);
    if (wr == 1) PG8_BAR;
    PG8_WAIT_V(2); PG8_BAR;
    PG8_STAGE(PG8_SB(1, 0), cB + kstep, voffB); PG8_STAGE(PG8_SA(1, 0), gA + kstep, vA[0]); PG8_STAGE(PG8_SB(1, 1), cB + hstep + kstep, voffB);
    PG8_WAIT_V(6); PG8_BAR;
    for (;;) {
        const bool has_next = S.next(ui + 1, nxt);
        if (has_next) { PG8_AOFFS(vN, nxt, ui + 1); } else {
#pragma unroll
            for (int h = 0; h < 2; ++h)
#pragma unroll
                for (int i = 0; i < 2; ++i) vN[h][i] = vA[h][i]; }
        const char* nB = has_next ? (const char*)g.Bt + (size_t)nxt.pb * tstep : cB;
        for (int t = 0; t < nt; t += 2) {
            const bool last = (t == nt - 2);
            const char* a1 = gA + (size_t)(t + 1) * kstep;
            const char* a2 = last ? gA : gA + (size_t)(t + 2) * kstep; const char* b2 = last ? nB : cB + (size_t)(t + 2) * kstep;
            const char* a3 = a2 + kstep; const char* b3 = b2 + kstep;
            unsigned v2[2][2];
#pragma unroll
            for (int h = 0; h < 2; ++h)
#pragma unroll
                for (int i = 0; i < 2; ++i) v2[h][i] = last ? vN[h][i] : vA[h][i];
            PG8_LDB(B0, 0, 0); PG8_LDB(B1, 0, 1); PG8_SCHED; PG8_LDA(At, 0, 0); PG8_STAGE(PG8_SA(1, 1), a1, vA[1]);
            PG8_WAIT_V(8); PG8_WAIT_L(0); PG8_BAR; PG8_MMA(0, 0, At, B0); PG8_MMA(0, 1, At, B1); PG8_BAR; PG8_SCHED;
            PG8_LDA(At, 0, 1); PG8_STAGE(PG8_SB(0, 0), b2, voffB); PG8_STAGE(PG8_SB(0, 1), b2 + hstep, voffB); PG8_STAGE(PG8_SA(0, 0), a2, v2[0]);
            PG8_WAIT_V(8); PG8_WAIT_L(0); PG8_BAR; PG8_MMA(1, 0, At, B0); PG8_MMA(1, 1, At, B1); PG8_BAR; PG8_SCHED;
            PG8_LDB(B0, 1, 0); PG8_LDB(B1, 1, 1); PG8_SCHED; PG8_LDA(At, 1, 0); PG8_STAGE(PG8_SA(0, 1), a2, v2[1]);
            PG8_WAIT_V(8); PG8_WAIT_L(0); PG8_BAR; PG8_MMA(0, 0, At, B0); PG8_MMA(0, 1, At, B1); PG8_BAR; PG8_SCHED;
            PG8_LDA(At, 1, 1); PG8_STAGE(PG8_SB(1, 0), b3, voffB); PG8_STAGE(PG8_SB(1, 1), b3 + hstep, voffB); PG8_STAGE(PG8_SA(1, 0), a3, v2[0]);
            PG8_WAIT_V(8); PG8_WAIT_L(0); PG8_BAR; PG8_MMA(1, 0, At, B0); PG8_MMA(1, 1, At, B1); PG8_BAR; PG8_SCHED;
        }
        if (wr == 0) PG8_BAR;
        if constexpr (F8) {
            asm volatile("s_nop 15\n\ts_nop 15" : "+v"(acc[0][0][0][0]), "+v"(acc[0][0][0][1]), "+v"(acc[0][0][1][0]), "+v"(acc[0][0][1][1]), "+v"(acc[0][0][2][0]), "+v"(acc[0][0][2][1]), "+v"(acc[0][0][3][0]), "+v"(acc[0][0][3][1]),
                         "+v"(acc[0][1][0][0]), "+v"(acc[0][1][0][1]), "+v"(acc[0][1][1][0]), "+v"(acc[0][1][1][1]), "+v"(acc[0][1][2][0]), "+v"(acc[0][1][2][1]), "+v"(acc[0][1][3][0]), "+v"(acc[0][1][3][1]));
            asm volatile("s_nop 0" : "+v"(acc[1][0][0][0]), "+v"(acc[1][0][0][1]), "+v"(acc[1][0][1][0]), "+v"(acc[1][0][1][1]), "+v"(acc[1][0][2][0]), "+v"(acc[1][0][2][1]), "+v"(acc[1][0][3][0]), "+v"(acc[1][0][3][1]),
                         "+v"(acc[1][1][0][0]), "+v"(acc[1][1][0][1]), "+v"(acc[1][1][1][0]), "+v"(acc[1][1][1][1]), "+v"(acc[1][1][2][0]), "+v"(acc[1][1][2][1]), "+v"(acc[1][1][3][0]), "+v"(acc[1][1][3][1]));
        }
        E(acc, cur, wr, wc, fr, fq);
        if (!has_next) break;
#pragma unroll
        for (int a = 0; a < 2; ++a)
#pragma unroll
            for (int b = 0; b < 2; ++b)
#pragma unroll
                for (int m = 0; m < 4; ++m)
#pragma unroll
                    for (int n = 0; n < 2; ++n) acc[a][b][m][n] = (f32x4){0.f, 0.f, 0.f, 0.f};
        cur = nxt; cB = nB; ++ui;
#pragma unroll
        for (int h = 0; h < 2; ++h)
#pragma unroll
            for (int i = 0; i < 2; ++i) vA[h][i] = vN[h][i];
        if (wr == 1) PG8_BAR;
    }
    PG8_WAIT_V(0);
    PG8_BAR;
#undef PG8_SA
#undef PG8_SB
#undef PG8_STAGE
#undef PG8_LDA
#undef PG8_LDB
#undef PG8_MMA
#undef PG8_WAIT_V
#undef PG8_WAIT_L
#undef PG8_BAR
#undef PG8_SCHED
#undef PG8_AOFFS
}

__device__ __forceinline__ u32x4 pack8(const f32x4& v0, const f32x4& v1) { u32x4 w; w.x = cvtpk(v0[0], v0[1]); w.y = cvtpk(v0[2], v0[3]); w.z = cvtpk(v1[0], v1[1]); w.w = cvtpk(v1[2], v1[3]); return w; }

struct EpiQKV {
    bf16_t* PB; bf16_t* QKV; const float* rope;
    __device__ __forceinline__ void operator()(const f32x4 (&acc)[2][2][4][2], const Unit& u, int wr, int wc, int fr, int fq) const {
        const int ct = u.pc * 256, region = ct / 512;
        const bool ropew = (region == 3 || region == 4) && ((wc & 1) == 0);
        const float qs = (region == 3) ? QSCALE : 1.0f;
        const float sgn = (fq == 0) ? -1.0f : 1.0f;
#pragma unroll
        for (int ai = 0; ai < 2; ++ai) {
            f32x4 cs[4][4];
            if (ropew) {
#pragma unroll
                for (int m = 0; m < 4; ++m) { const int r = u.pm * 256 + ai * 128 + wr * 64 + m * 16 + fr;
#pragma unroll
                    for (int i = 0; i < 4; ++i) cs[m][i] = *(const f32x4*)(rope + (size_t)r * 16 + 4 * i); }
            }
            __builtin_amdgcn_sched_barrier(0);
#pragma unroll
            for (int m = 0; m < 4; ++m) {
                const int r = u.pm * 256 + ai * 128 + wr * 64 + m * 16 + fr;
#pragma unroll
                for (int bj = 0; bj < 2; ++bj) {
                    f32x4 v0 = acc[ai][bj][m][0], v1 = acc[ai][bj][m][1];
                    if (ropew) {
                        f32x4 p0, p1;
#pragma unroll
                        for (int j = 0; j < 4; ++j) { p0[j] = __shfl_xor(v0[j], 16); p1[j] = __shfl_xor(v1[j], 16); }
                        if (fq < 2) {
                            v0[0] = v0[0] * cs[m][0][0] + sgn * p0[0] * cs[m][0][1]; v0[1] = v0[1] * cs[m][0][2] + sgn * p0[1] * cs[m][0][3];
                            v0[2] = v0[2] * cs[m][1][0] + sgn * p0[2] * cs[m][1][1]; v0[3] = v0[3] * cs[m][1][2] + sgn * p0[3] * cs[m][1][3];
                            v1[0] = v1[0] * cs[m][2][0] + sgn * p1[0] * cs[m][2][1]; v1[1] = v1[1] * cs[m][2][2] + sgn * p1[1] * cs[m][2][3];
                            v1[2] = v1[2] * cs[m][3][0] + sgn * p1[2] * cs[m][3][1]; v1[3] = v1[3] * cs[m][3][2] + sgn * p1[3] * cs[m][3][3];
                        }
                    }
                    v0 = v0 * qs; v1 = v1 * qs;
                    if (u.pc < 2) *(u32x4*)(PB + (size_t)r * PBW + ct + bj * 128 + wc * 32 + 8 * fq) = pack8(v0, v1);
                    else if (u.pc < 6) { if (bj == 0) *(u32x4*)(PB + (size_t)r * PBW + 512 + (u.pc - 2) * 128 + wc * 32 + 8 * fq) = pack8(acc[ai][0][m][0] * acc[ai][1][m][0], acc[ai][0][m][1] * acc[ai][1][m][1]); }
                    else { const int hd = ((ct - region * 512) >> 6) + 2 * bj + (wc >> 1), d = 32 * (wc & 1) + 8 * fq, bb = r >> 11, ss = r & (SEQ - 1);
                        *(u32x4*)(QKV + (size_t)(region - 3) * ((size_t)M * 512) + ((size_t)(bb * NH + hd) * SEQ + ss) * 64 + d) = pack8(v0, v1); }
                }
            }
            __builtin_amdgcn_sched_barrier(0);
        }
    }
};
struct EpiRes {
    const bf16_t* XNb; const float* irstd; bf16_t* X1; bf16_t* XN2;
    __device__ __forceinline__ void operator()(const f32x4 (&acc)[2][2][4][2], const Unit& u, int wr, int wc, int fr, int fq) const {
        const size_t base = (size_t)(u.pm * 256 + wr * 64 + fr) * DM + u.pc * 256 + wc * 32 + 8 * fq;
        float ir[2][4];
#pragma unroll
        for (int ai = 0; ai < 2; ++ai)
#pragma unroll
            for (int m = 0; m < 4; ++m) ir[ai][m] = irstd[u.pm * 256 + ai * 128 + wr * 64 + m * 16 + fr];
        u32x4 xa[2][2], xb[2][2];
#define ER_OFF(b, mm, bj) (base + (size_t)(((b) >> 1) * 128 + (2 * ((b) & 1) + (mm)) * 16) * DM + (bj) * 128)
#define ER_LOAD(X, b) do { _Pragma("unroll") for (int mm = 0; mm < 2; ++mm) _Pragma("unroll") for (int bj = 0; bj < 2; ++bj) X[mm][bj] = *(const u32x4*)(XNb + ER_OFF(b, mm, bj)); } while (0)
#define ER_PROC(X, b) do { _Pragma("unroll") for (int mm = 0; mm < 2; ++mm) _Pragma("unroll") for (int bj = 0; bj < 2; ++bj) { const size_t off = ER_OFF(b, mm, bj); \
            const float iq = ir[(b) >> 1][2 * ((b) & 1) + mm]; const u32x4 xw = X[mm][bj]; \
            const f32x4 v0 = acc[(b) >> 1][bj][2 * ((b) & 1) + mm][0] + (f32x4){bf_lo(xw.x), bf_hi(xw.x), bf_lo(xw.y), bf_hi(xw.y)} * iq, v1 = acc[(b) >> 1][bj][2 * ((b) & 1) + mm][1] + (f32x4){bf_lo(xw.z), bf_hi(xw.z), bf_lo(xw.w), bf_hi(xw.w)} * iq; \
            *(u32x4*)(X1 + off) = pack8(v0, v1); \
            if (EXP_FP8) { u32x2 w; w.x = cvt4_fp8(v0[0], v0[1], v0[2], v0[3]); w.y = cvt4_fp8(v1[0], v1[1], v1[2], v1[3]); *(u32x2*)((unsigned char*)XN2 + off) = w; } \
            else *(u32x4*)(XN2 + off) = pack8(v0, v1); } } while (0)
        ER_LOAD(xa, 0); ER_LOAD(xb, 1); __builtin_amdgcn_sched_barrier(0);
        ER_PROC(xa, 0); ER_LOAD(xa, 2); __builtin_amdgcn_sched_barrier(0);
        ER_PROC(xb, 1); ER_LOAD(xb, 3); __builtin_amdgcn_sched_barrier(0);
        ER_PROC(xa, 2); __builtin_amdgcn_sched_barrier(0);
        ER_PROC(xb, 3);
#undef ER_OFF
#undef ER_LOAD
#undef ER_PROC
    }
};
struct EpiSwiGLU {
    bf16_t* H; const float* rsg;
    __device__ __forceinline__ void operator()(const f32x4 (&acc)[2][2][4][2], const Unit& u, int wr, int wc, int fr, int fq) const {
        float rsv[2][4];
#pragma unroll
        for (int ai = 0; ai < 2; ++ai)
#pragma unroll
            for (int m = 0; m < 4; ++m) rsv[ai][m] = rsg[u.pm * 256 + ai * 128 + wr * 64 + m * 16 + fr];
        __builtin_amdgcn_sched_barrier(0);
#pragma unroll
        for (int ai = 0; ai < 2; ++ai)
#pragma unroll
            for (int m = 0; m < 4; ++m) {
                const int r = u.pm * 256 + ai * 128 + wr * 64 + m * 16 + fr;
                const float rs = rsv[ai][m];
                f32x4 h[2];
#pragma unroll
                for (int n = 0; n < 2; ++n)
#pragma unroll
                    for (int j = 0; j < 4; ++j) {
                        const float gv = acc[ai][0][m][n][j] * rs, uv = acc[ai][1][m][n][j] * rs;
                        const float sg = __builtin_amdgcn_rcpf(1.0f + __builtin_amdgcn_exp2f(-1.4426950408889634f * gv));
                        h[n][j] = gv * sg * uv;
                    }
                if (EXP_FP8) { u32x2 w; w.x = cvt4_fp8(h[0][0], h[0][1], h[0][2], h[0][3]); w.y = cvt4_fp8(h[1][0], h[1][1], h[1][2], h[1][3]); *(u32x2*)((unsigned char*)H + (size_t)r * DFF + u.pc * 128 + wc * 32 + 8 * fq) = w; }
                else *(u32x4*)(H + (size_t)r * DFF + u.pc * 128 + wc * 32 + 8 * fq) = pack8(h[0], h[1]);
            }
    }
};
struct EpiContrib {
    bf16_t* CN; const float* gatev;
    __device__ __forceinline__ void operator()(const f32x4 (&acc)[2][2][4][2], const Unit& u, int wr, int wc, int fr, int fq) const {
        float gv[2][4];
#pragma unroll
        for (int ai = 0; ai < 2; ++ai)
#pragma unroll
            for (int m = 0; m < 4; ++m) gv[ai][m] = gatev[u.pm * 256 + ai * 128 + wr * 64 + m * 16 + fr] * (EXP_FP8 ? W8_INV * CN_SCALE : 1.0f);
        __builtin_amdgcn_sched_barrier(0);
#pragma unroll
        for (int ai = 0; ai < 2; ++ai)
#pragma unroll
            for (int m = 0; m < 4; ++m) {
                const int r = u.pm * 256 + ai * 128 + wr * 64 + m * 16 + fr;
                const float gt = gv[ai][m];
#pragma unroll
                for (int bj = 0; bj < 2; ++bj) {
                    const f32x4 c0 = acc[ai][bj][m][0] * gt, c1 = acc[ai][bj][m][1] * gt;
                    if (EXP_FP8) { u32x2 w; w.x = cvt4_fp8(c0[0], c0[1], c0[2], c0[3]); w.y = cvt4_fp8(c1[0], c1[1], c1[2], c1[3]); *(u32x2*)((unsigned char*)CN + (size_t)r * DM + u.pc * 256 + bj * 128 + wc * 32 + 8 * fq) = w; }
                    else *(u32x4*)(CN + (size_t)r * DM + u.pc * 256 + bj * 128 + wc * 32 + 8 * fq) = pack8(c0, c1); }
            }
    }
};

typedef short v4i16_t __attribute__((ext_vector_type(4)));
__device__ __forceinline__ u32x2 lds_tr16(LAS unsigned char* p) { return __builtin_bit_cast(u32x2, __builtin_amdgcn_ds_read_tr16_b64_v4i16((LAS v4i16_t*)p)); }
__device__ __forceinline__ void transpose_item(const float* W, int ldn, const float* kscale, bf16_t* WT, int ldk, int k0, int n0, size_t dst_row0, LAS unsigned char* scr, int lane) {
    const int lr = lane >> 4, lc = lane & 15;
    f32x4 v[16]; float sc[16];
    const float* src = W + (size_t)(k0 + lr) * ldn + n0 + 4 * lc;
#pragma unroll
    for (int i = 0; i < 16; ++i) v[i] = __builtin_nontemporal_load((const f32x4*)(src + (size_t)(4 * i) * ldn));
    if (kscale) {
#pragma unroll
        for (int i = 0; i < 16; ++i) sc[i] = kscale[k0 + 4 * i + lr];
    } else {
#pragma unroll
        for (int i = 0; i < 16; ++i) sc[i] = 1.0f;
    }
#pragma unroll
    for (int i = 0; i < 16; ++i) { u32x2 w; w.x = cvtpk(v[i].x * sc[i], v[i].y * sc[i]); w.y = cvtpk(v[i].z * sc[i], v[i].w * sc[i]); *(LAS u32x2*)(scr + (4 * i + lr) * 128 + 8 * lc) = w; }
    LDS_WAIT(); asm volatile("" ::: "memory");
    const int gi = lane >> 4, q = (lane & 15) >> 2, p = lane & 3;
#pragma unroll
    for (int nb = 0; nb < 4; ++nb)
#pragma unroll
        for (int kh = 0; kh < 2; ++kh) {
            const int kb = 8 * (4 * kh + gi);
            LAS unsigned char* a = scr + (kb + q) * 128 + (16 * nb + 4 * p) * 2;
            const u32x2 lo = lds_tr16(a), hi = lds_tr16(a + 512);
            u32x4 o; o.x = lo.x; o.y = lo.y; o.z = hi.x; o.w = hi.y;
            __builtin_nontemporal_store(o, (u32x4*)(WT + (dst_row0 + 16 * nb + (lane & 15)) * (size_t)ldk + k0 + kb));
        }
    LDS_WAIT(); asm volatile("" ::: "memory");
}
struct CvItem { const float* W; const float* ks; unsigned char* WT; int ldn, ldk, k0, n0; size_t row0; };
__device__ __forceinline__ void cv_load(const CvItem& c, f32x4 (&v)[16], float (&sc)[16], int lane) {
    const int lr = lane >> 4, lc = lane & 15;
    const float* src = c.W + (size_t)(c.k0 + lr) * c.ldn + c.n0 + 4 * lc;
#pragma unroll
    for (int i = 0; i < 16; ++i) v[i] = __builtin_nontemporal_load((const f32x4*)(src + (size_t)(4 * i) * c.ldn));
    if (c.ks) {
#pragma unroll
        for (int i = 0; i < 16; ++i) sc[i] = c.ks[c.k0 + 4 * i + lr];
    } else {
#pragma unroll
        for (int i = 0; i < 16; ++i) sc[i] = 1.0f;
    }
}
__device__ __forceinline__ void cv_finish_f8(const CvItem& c, const f32x4 (&v)[16], const float (&sc)[16], float mult, LAS unsigned char* scr, int lane) {
    const int lr = lane >> 4, lc = lane & 15;
#pragma unroll
    for (int i = 0; i < 16; ++i) { const float m = sc[i] * mult; u32x2 w; w.x = cvtpk(v[i].x * m, v[i].y * m); w.y = cvtpk(v[i].z * m, v[i].w * m); *(LAS u32x2*)(scr + (4 * i + lr) * 128 + 8 * lc) = w; }
    LDS_WAIT(); asm volatile("" ::: "memory");
    const int gi = lane >> 4, q = (lane & 15) >> 2, p = lane & 3;
#pragma unroll
    for (int nb = 0; nb < 4; ++nb) {
        LAS unsigned char* a = scr + (16 * gi + q) * 128 + (16 * nb + 4 * p) * 2;
        u32x4 o;
#pragma unroll
        for (int r = 0; r < 4; ++r) { const u32x2 t = lds_tr16(a + r * 512); o[r] = cvt4_fp8(bf_lo(t.x), bf_hi(t.x), bf_lo(t.y), bf_hi(t.y)); }
        __builtin_nontemporal_store(o, (u32x4*)(c.WT + (c.row0 + 16 * nb + (lane & 15)) * (size_t)c.ldk + c.k0 + 16 * gi));
    }
    LDS_WAIT(); asm volatile("" ::: "memory");
}
__device__ __forceinline__ void transpose_item_f8(const float* W, int ldn, const float* kscale, float mult, unsigned char* WT, int ldk, int k0, int n0, size_t dst_row0, LAS unsigned char* scr, int lane) {
    CvItem c{W, kscale, WT, ldn, ldk, k0, n0, dst_row0}; f32x4 v[16]; float sc[16];
    cv_load(c, v, sc, lane); cv_finish_f8(c, v, sc, mult, scr, lane);
}
constexpr int I_IN = 16 * 48, I_OUT = 16 * 16, I_G = 16 * 16 * 32, I_D = 16 * 32 * 16, NITEMS = I_IN + I_OUT + 2 * I_G + I_D;
__device__ __forceinline__ void convert_items(Frame& F, int first, int last, LAS unsigned char* scr, int r_lo = 0, int r_hi = 1 << 20, int gw_ = -1, int ngw_ = 0) {
    const int gw = gw_ >= 0 ? gw_ : F.vcu * NWAVES + F.wave, NGW = gw_ >= 0 ? ngw_ : F.G * NWAVES;
    bf16_t* Win_t = (bf16_t*)(F.ws + WS_WIN); bf16_t* Wout_t = (bf16_t*)(F.ws + WS_WOUT); bf16_t* Wgu_t = (bf16_t*)(F.ws + WS_WGU); bf16_t* Wd_t = (bf16_t*)(F.ws + WS_WD);
    int rd = r_lo, it = first + gw + r_lo * NGW;
    for (; rd < r_hi && it < last && it < I_IN + I_OUT; ++rd, it += NGW) {
        int r = it;
        if (r < I_IN) { const int kb = r / 48, nb = r % 48, n0 = 64 * nb;
            const int drow = (n0 < 512 || n0 >= 1536) ? n0 : (n0 < 1024 ? 512 + ((n0 - 512) / 128) * 256 + ((n0 - 512) % 128) : 512 + ((n0 - 1024) / 128) * 256 + 128 + ((n0 - 1024) % 128));
            transpose_item(F.w_in, PW, F.g_mix, Win_t, DM, 64 * kb, n0, drow, scr, F.lane); continue; } r -= I_IN;
        { const int kb = r / 16, nb = r % 16; const float* ks = (kb < 8) ? F.g_conv : (F.g_attn - 512); transpose_item(F.w_out, DM, ks, Wout_t, DM, 64 * kb, 64 * nb, 64 * nb, scr, F.lane); }
    }
    if (EXP_FP8) {
#define CV_MAKE(c, item) do { int r_ = (item) - I_IN - I_OUT; if (r_ < 2 * I_G) { const int which = r_ / I_G; r_ %= I_G; const int e = r_ / 512, q = r_ % 512, kb = q / 32, nb = q % 32, n0 = 64 * nb; \
            c.W = (which ? F.w_up : F.w_gate) + (size_t)e * DM * DFF; c.ks = F.g_ffn; c.WT = (unsigned char*)Wgu_t + (size_t)e * 4096 * DM; c.ldn = DFF; c.ldk = DM; c.k0 = 64 * kb; c.n0 = n0; c.row0 = (size_t)(n0 / 128) * 256 + which * 128 + (n0 % 128); } \
          else { r_ -= 2 * I_G; const int e = r_ / 512, q = r_ % 512, kb = q / 16, nb = q % 16; \
            c.W = F.w_down + (size_t)e * DFF * DM; c.ks = nullptr; c.WT = (unsigned char*)Wd_t + (size_t)e * DM * DFF; c.ldn = DM; c.ldk = DFF; c.k0 = 64 * kb; c.n0 = 64 * nb; c.row0 = (size_t)(64 * nb); } } while (0)
        if (rd < r_hi && it < last) {
            f32x4 va[16], vb[16]; float sa[16], sb[16];
            { CvItem c; CV_MAKE(c, it); cv_load(c, va, sa, F.lane); }
            for (;;) {
                bool more = (rd + 1 < r_hi) && (it + NGW < last);
                if (more) { CvItem c; CV_MAKE(c, it + NGW); cv_load(c, vb, sb, F.lane); }
                __builtin_amdgcn_sched_barrier(0);
                { CvItem c; CV_MAKE(c, it); cv_finish_f8(c, va, sa, W8_SCALE, scr, F.lane); }
                if (!more) break;
                ++rd; it += NGW;
                more = (rd + 1 < r_hi) && (it + NGW < last);
                if (more) { CvItem c; CV_MAKE(c, it + NGW); cv_load(c, va, sa, F.lane); }
                __builtin_amdgcn_sched_barrier(0);
                { CvItem c; CV_MAKE(c, it); cv_finish_f8(c, vb, sb, W8_SCALE, scr, F.lane); }
                if (!more) break;
                ++rd; it += NGW;
            }
        }
#undef CV_MAKE
        return;
    }
    for (; rd < r_hi && it < last; ++rd, it += NGW) {
        int r = it;
        if (r < I_IN) { const int kb = r / 48, nb = r % 48, n0 = 64 * nb;
            const int drow = (n0 < 512 || n0 >= 1536) ? n0 : (n0 < 1024 ? 512 + ((n0 - 512) / 128) * 256 + ((n0 - 512) % 128) : 512 + ((n0 - 1024) / 128) * 256 + 128 + ((n0 - 1024) % 128));
            transpose_item(F.w_in, PW, F.g_mix, Win_t, DM, 64 * kb, n0, drow, scr, F.lane); continue; } r -= I_IN;
        if (r < I_OUT) { const int kb = r / 16, nb = r % 16; const float* ks = (kb < 8) ? F.g_conv : (F.g_attn - 512); transpose_item(F.w_out, DM, ks, Wout_t, DM, 64 * kb, 64 * nb, 64 * nb, scr, F.lane); continue; } r -= I_OUT;
        if (r < 2 * I_G) { const int which = r / I_G; r %= I_G; const int e = r / 512, q = r % 512, kb = q / 32, nb = q % 32, n0 = 64 * nb;
            const float* W = (which ? F.w_up : F.w_gate) + (size_t)e * DM * DFF;
            if (EXP_FP8) transpose_item_f8(W, DFF, F.g_ffn, W8_SCALE, (unsigned char*)Wgu_t + (size_t)e * 4096 * DM, DM, 64 * kb, n0, (size_t)(n0 / 128) * 256 + which * 128 + (n0 % 128), scr, F.lane);
            else transpose_item(W, DFF, F.g_ffn, Wgu_t + (size_t)e * 4096 * DM, DM, 64 * kb, n0, (size_t)(n0 / 128) * 256 + which * 128 + (n0 % 128), scr, F.lane); continue; } r -= 2 * I_G;
        { const int e = r / 512, q = r % 512, kb = q / 16, nb = q % 16;
            if (EXP_FP8) transpose_item_f8(F.w_down + (size_t)e * DFF * DM, DM, nullptr, W8_SCALE, (unsigned char*)Wd_t + (size_t)e * DM * DFF, DFF, 64 * kb, 64 * nb, 64 * nb, scr, F.lane);
            else transpose_item(F.w_down + (size_t)e * DFF * DM, DM, nullptr, Wd_t + (size_t)e * DM * DFF, DFF, 64 * kb, 64 * nb, 64 * nb, scr, F.lane); }
    }
}
__device__ __forceinline__ void p0_prologue(Frame& F) {
    const int gw = F.vcu * NWAVES + F.wave, NGW = F.G * NWAVES;
    convert_items(F, 0, OVERLAP_CONV ? I_IN : NITEMS, F.lds + F.wave * 16384, 0, 1 << 20, F.wave * F.G + F.vcu, F.G * NWAVES);
    bf16_t* XN = (bf16_t*)(F.ws + WS_XN);
    for (int m0 = gw * 8; m0 < M; m0 += NGW * 8) {
        f32x4 v[8][4];
#pragma unroll
        for (int rr = 0; rr < 8; ++rr) { const f32x4* xr = (const f32x4*)(F.x + (size_t)(m0 + rr) * DM) + F.lane;
#pragma unroll
            for (int j = 0; j < 4; ++j) v[rr][j] = xr[64 * j]; }
        __builtin_amdgcn_sched_barrier(0);
#pragma unroll
        for (int rr = 0; rr < 8; ++rr) {
            float ss = 0.f;
#pragma unroll
            for (int j = 0; j < 4; ++j) ss += (v[rr][j].x * v[rr][j].x + v[rr][j].y * v[rr][j].y) + (v[rr][j].z * v[rr][j].z + v[rr][j].w * v[rr][j].w);
            const float rstd = 1.0f / sqrtf(wave_sum(ss) * (1.f / DM) + RMS_EPS);
            if (F.lane == 0) ((float*)(F.ws + WS_IRSTD1))[m0 + rr] = 1.0f / rstd;
            u32x2* o = (u32x2*)(XN + (size_t)(m0 + rr) * DM) + F.lane;
#pragma unroll
            for (int j = 0; j < 4; ++j) { u32x2 w; w.x = cvtpk(v[rr][j].x * rstd, v[rr][j].y * rstd); w.y = cvtpk(v[rr][j].z * rstd, v[rr][j].w * rstd); o[64 * j] = w; }
        }
    }
    float* rope = (float*)(F.ws + WS_ROPE);
    for (int i = (F.vcu * NTHREADS + F.tid); i < M * 8; i += F.G * NTHREADS) {
        const int tok = i >> 3, f = i & 7;
        const float invf = (f == 0) ? 1.0f : (f == 1) ? 0.19392274474868576f : (f == 2) ? 0.037606030930863933f : (f == 3) ? 0.0072926647372171093f : (f == 4) ? 0.001414213562373095f : (f == 5) ? 0.0002742481756762073f : (f == 6) ? 5.3182958969449883e-05f : 1.031338537721246e-05f;
        const float ang = (float)F.pos[tok] * invf;
        float sn, cs; sincosf(ang, &sn, &cs);
        rope[2 * i] = cs; rope[2 * i + 1] = sn;
    }
}

__device__ __forceinline__ int crow(int r, int hi) { return (r & 3) + 8 * (r >> 2) + 4 * hi; }
struct QBlk { bf16x8 qr[4]; f32x16 o0, o1; float m, l; };
__device__ __forceinline__ void att_block_step(QBlk& q, const bf16x8 (&kf)[4], const bf16x8 (&vA)[2], const bf16x8 (&vC)[2], bool masked, int lq, int lk0, int hi) {
    f32x16 p = {};
#pragma unroll
    for (int d0 = 0; d0 < 4; ++d0) p = __builtin_amdgcn_mfma_f32_32x32x16_bf16(kf[d0], q.qr[d0], p, 0, 0, 0);
    if (masked) {
#pragma unroll
        for (int r = 0; r < 16; ++r) { const int dd = lq - (lk0 + crow(r, hi)); if (dd > 64 || dd < -64) p[r] = -1e30f; } }
    float mx = p[0];
#pragma unroll
    for (int r = 1; r < 16; ++r) mx = fmaxf(mx, p[r]);
    mx = fmaxf(mx, __shfl_xor(mx, 32));
    const float mnew = fmaxf(q.m, mx);
    const float alpha = __builtin_amdgcn_exp2f(q.m - mnew);
    float rs = 0.f;
#pragma unroll
    for (int r = 0; r < 16; ++r) { p[r] = __builtin_amdgcn_exp2f(p[r] - mnew); rs += p[r]; }
    q.l = q.l * alpha + rs;
    if (__any(mnew > q.m)) {
#pragma unroll
        for (int r = 0; r < 16; ++r) { q.o0[r] *= alpha; q.o1[r] *= alpha; } }
    q.m = mnew;
#pragma unroll
    for (int s2 = 0; s2 < 2; ++s2) {
        u32x4 wv; wv.x = cvtpk(p[8 * s2 + 0], p[8 * s2 + 1]); wv.y = cvtpk(p[8 * s2 + 2], p[8 * s2 + 3]); wv.z = cvtpk(p[8 * s2 + 4], p[8 * s2 + 5]); wv.w = cvtpk(p[8 * s2 + 6], p[8 * s2 + 7]);
        const bf16x8 pf = __builtin_bit_cast(bf16x8, wv);
        q.o0 = __builtin_amdgcn_mfma_f32_32x32x16_bf16(vA[s2], pf, q.o0, 0, 0, 0);
        q.o1 = __builtin_amdgcn_mfma_f32_32x32x16_bf16(vC[s2], pf, q.o1, 0, 0, 0);
    }
}
__device__ __forceinline__ void att_block_store(const QBlk& q, bf16_t* op, float* mlp, int hi) {
    const float ltot = q.l + __shfl_xor(q.l, 32);
    const float il = 1.0f / ltot;
#pragma unroll
    for (int g4 = 0; g4 < 4; ++g4) {
        u32x2 w0, w1;
        w0.x = cvtpk(q.o0[4 * g4 + 0] * il, q.o0[4 * g4 + 1] * il); w0.y = cvtpk(q.o0[4 * g4 + 2] * il, q.o0[4 * g4 + 3] * il);
        w1.x = cvtpk(q.o1[4 * g4 + 0] * il, q.o1[4 * g4 + 1] * il); w1.y = cvtpk(q.o1[4 * g4 + 2] * il, q.o1[4 * g4 + 3] * il);
        *(u32x2*)(op + 8 * g4 + 4 * hi) = w0; *(u32x2*)(op + 32 + 8 * g4 + 4 * hi) = w1;
    }
    if (hi == 0) { f32x2 ml = {q.m, ltot}; *(f32x2*)mlp = ml; }
}
__device__ __forceinline__ void att_softmax_nb(QBlk& q, f32x16& p, bf16x8 (&pf)[2]) {
    float mx = p[0];
#pragma unroll
    for (int r = 1; r < 16; ++r) mx = fmaxf(mx, p[r]);
    mx = fmaxf(mx, __shfl_xor(mx, 32));
    const float mnew = fmaxf(q.m, mx);
    const float alpha = __builtin_amdgcn_exp2f(q.m - mnew);
    float rs = 0.f;
#pragma unroll
    for (int r = 0; r < 16; ++r) { p[r] = __builtin_amdgcn_exp2f(p[r] - mnew); rs += p[r]; }
    q.l = q.l * alpha + rs; q.m = mnew;
#pragma unroll
    for (int r = 0; r < 16; ++r) { q.o0[r] *= alpha; q.o1[r] *= alpha; }
#pragma unroll
    for (int s2 = 0; s2 < 2; ++s2) {
        u32x4 wv; wv.x = cvtpk(p[8 * s2 + 0], p[8 * s2 + 1]); wv.y = cvtpk(p[8 * s2 + 2], p[8 * s2 + 3]); wv.z = cvtpk(p[8 * s2 + 4], p[8 * s2 + 5]); wv.w = cvtpk(p[8 * s2 + 6], p[8 * s2 + 7]);
        pf[s2] = __builtin_bit_cast(bf16x8, wv); }
}
template <int DA, int DB>
__device__ __forceinline__ void att_pair_step(QBlk& a, QBlk& b, const bf16x8 (&kf)[4], const bf16x8 (&vA)[2], const bf16x8 (&vC)[2], const f32x16& bm, const f32x16& bp) {
    f32x16 pa = {}, pb = {};
    if constexpr (DA != 9) { pa = (DA == -2) ? bm : (DA == 2) ? bp : f32x16{};
#pragma unroll
        for (int d0 = 0; d0 < 4; ++d0) pa = __builtin_amdgcn_mfma_f32_32x32x16_bf16(kf[d0], a.qr[d0], pa, 0, 0, 0); }
    if constexpr (DB != 9) { pb = (DB == -2) ? bm : (DB == 2) ? bp : f32x16{};
#pragma unroll
        for (int d0 = 0; d0 < 4; ++d0) pb = __builtin_amdgcn_mfma_f32_32x32x16_bf16(kf[d0], b.qr[d0], pb, 0, 0, 0); }
    bf16x8 fa[2], fb[2];
    if constexpr (DA != 9) att_softmax_nb(a, pa, fa);
    if constexpr (DB != 9) att_softmax_nb(b, pb, fb);
    if constexpr (DA != 9) {
#pragma unroll
        for (int s2 = 0; s2 < 2; ++s2) { a.o0 = __builtin_amdgcn_mfma_f32_32x32x16_bf16(vA[s2], fa[s2], a.o0, 0, 0, 0); a.o1 = __builtin_amdgcn_mfma_f32_32x32x16_bf16(vC[s2], fa[s2], a.o1, 0, 0, 0); } }
    if constexpr (DB != 9) {
#pragma unroll
        for (int s2 = 0; s2 < 2; ++s2) { b.o0 = __builtin_amdgcn_mfma_f32_32x32x16_bf16(vA[s2], fb[s2], b.o0, 0, 0, 0); b.o1 = __builtin_amdgcn_mfma_f32_32x32x16_bf16(vC[s2], fb[s2], b.o1, 0, 0, 0); } }
}
template <int NWA> __device__ __forceinline__ void p2a_attention_w(Frame& F, int it_lo = 0, int it_hi = 1 << 30) {
    const bf16_t* QH = (const bf16_t*)(F.ws + WS_QH); const bf16_t* KH = (const bf16_t*)(F.ws + WS_KH); const bf16_t* VH = (const bf16_t*)(F.ws + WS_VH);
    bf16_t* OP = (bf16_t*)(F.ws + WS_OP); float* ML = (float*)(F.ws + WS_ML);
    const int NGW = F.G * NWA;
    constexpr int NTASK = BATCH * NH * 3 * 32;
    const int per = (NTASK + NGW - 1) / NGW;
    const int lane = F.lane, r32 = lane & 31, hi = lane >> 5;
    if (F.wave >= NWA) return;
    LAS unsigned char* kt_l = F.lds + F.wave * 16384;
    LAS unsigned char* vt_l = kt_l + 8192;
    const int vrow = lane >> 3, vch = lane & 7;
    const int ksrc = (vch ^ (vrow & 7)) * 8;
    LAS unsigned char* vtr = vt_l + (4 * hi + ((lane & 15) >> 2)) * 128 + (16 * ((lane >> 4) & 1) + 4 * (lane & 3)) * 2;
    LAS unsigned char* krd = kt_l + r32 * 128;
#define ATT_DMA(kt_, slot_) do { \
        _Pragma("unroll") for (int j = 0; j < 4; ++j) { const size_t ro = (size_t)((32 * (kt_) + vrow + 8 * j) * dl) * 64; \
            __builtin_amdgcn_global_load_lds((const unsigned*)(kbase + ro + ksrc), (LAS unsigned*)(kt_l + (slot_) * 4096 + j * 1024), 16, 0, 0); \
            __builtin_amdgcn_global_load_lds((const unsigned*)(vbase + ro + vch * 8), (LAS unsigned*)(vt_l + (slot_) * 4096 + j * 1024), 16, 0, 0); } } while (0)
    f32x16 bm, bp;
#pragma unroll
    for (int r = 0; r < 16; ++r) { bm[r] = (crow(r, hi) >= r32) ? 0.f : -1e30f; bp[r] = (crow(r, hi) <= r32) ? 0.f : -1e30f; }
    for (int it = it_lo; it < per && it < it_hi; ++it) {
        const int cpx = (F.G >= 8) ? (F.G >> 3) : 1, xg = F.vcu / cpx, jc = F.vcu % cpx;
        const int T = xg * (per * NWA * cpx) + it * (NWA * cpx) + jc * NWA + F.wave;
        if (T >= NTASK) continue;
        const int bh = T / 96, w = T % 96, pi = w / 32, a2 = w % 32;
        const int dl = (pi == 0) ? 1 : (pi == 1 ? 4 : 16);
        const int L = SEQ / dl, tpc = L / 32, hpc = tpc >> 1, rc = a2 / hpc, ta = 2 * (a2 % hpc);
        const size_t hb = (size_t)bh * SEQ;
        const bf16_t* kbase = KH + (hb + rc) * 64;
        const bf16_t* vbase = VH + (hb + rc) * 64;
        const int klo = (ta - 2 < 0) ? 0 : ta - 2, khi = (ta + 3 > tpc - 1) ? tpc - 1 : ta + 3, nt = khi - klo + 1;
        QBlk qa, qb;
        const int qposa = (32 * ta + r32) * dl + rc, qposb = qposa + 32 * dl;
#pragma unroll
        for (int d0 = 0; d0 < 4; ++d0) { qa.qr[d0] = *(const bf16x8*)(QH + (hb + qposa) * 64 + hi * 8 + d0 * 16); qb.qr[d0] = *(const bf16x8*)(QH + (hb + qposb) * 64 + hi * 8 + d0 * 16); }
        ATT_DMA(klo, 0);
        if (nt > 1) ATT_DMA(klo + 1, 1);
        qa.m = -1e30f; qa.l = 0.f; qa.o0 = f32x16{}; qa.o1 = f32x16{}; qb.m = -1e30f; qb.l = 0.f; qb.o0 = f32x16{}; qb.o1 = f32x16{};
#define ATT_TILE2(i_, DA_, DB_) do { const int kt = ta - 2 + (i_); if (kt >= 0 && kt < tpc) { \
            if ((i_) < 5 && kt + 1 < tpc) asm volatile("s_waitcnt vmcnt(8)" ::: "memory"); else asm volatile("s_waitcnt vmcnt(0)" ::: "memory"); \
            bf16x8 kf[4], vA[2], vC[2]; \
            _Pragma("unroll") for (int d0 = 0; d0 < 4; ++d0) kf[d0] = *(const LAS bf16x8*)(krd + ((i_) & 1) * 4096 + ((2 * d0 + hi) ^ (r32 & 7)) * 16); \
            LAS unsigned char* vs = vtr + ((i_) & 1) * 4096; \
            _Pragma("unroll") for (int s2 = 0; s2 < 2; ++s2) { \
                const u32x2 a0 = lds_tr16(vs + s2 * 2048), a1 = lds_tr16(vs + s2 * 2048 + 1024); \
                const u32x2 c0 = lds_tr16(vs + s2 * 2048 + 64), c1 = lds_tr16(vs + s2 * 2048 + 1024 + 64); \
                u32x4 va, vc; va.x = a0.x; va.y = a0.y; va.z = a1.x; va.w = a1.y; vc.x = c0.x; vc.y = c0.y; vc.z = c1.x; vc.w = c1.y; \
                vA[s2] = __builtin_bit_cast(bf16x8, va); vC[s2] = __builtin_bit_cast(bf16x8, vc); } \
            LDS_WAIT(); __builtin_amdgcn_sched_barrier(0); \
            if ((i_) + 2 <= 5 && kt + 2 < tpc) ATT_DMA(kt + 2, (i_) & 1); \
            __builtin_amdgcn_sched_barrier(0); \
            att_pair_step<DA_, DB_>(qa, qb, kf, vA, vC, bm, bp); \
        } } while (0)
        ATT_TILE2(0, -2, 9); ATT_TILE2(1, -1, -2); ATT_TILE2(2, 0, -1); ATT_TILE2(3, 1, 0); ATT_TILE2(4, 2, 1); ATT_TILE2(5, 9, 2);
#undef ATT_TILE2
        const size_t toka = (size_t)(bh >> 3) * SEQ + qposa, tokb = (size_t)(bh >> 3) * SEQ + qposb;
        att_block_store(qa, OP + ((size_t)pi * M + toka) * 512 + (bh & 7) * 64, ML + (((size_t)pi * M + toka) * 8 + (bh & 7)) * 2, hi);
        att_block_store(qb, OP + ((size_t)pi * M + tokb) * 512 + (bh & 7) * 64, ML + (((size_t)pi * M + tokb) * 8 + (bh & 7)) * 2, hi);
    }
#undef ATT_DMA
}
__device__ __forceinline__ void p2a_attention(Frame& F, int it_lo = 0, int it_hi = 1 << 30) { p2a_attention_w<NWAVES>(F, it_lo, it_hi); }

__device__ __forceinline__ void unpack8(const u32x4 w, float (&o)[8]) { o[0] = bf_lo(w.x); o[1] = bf_hi(w.x); o[2] = bf_lo(w.y); o[3] = bf_hi(w.y); o[4] = bf_lo(w.z); o[5] = bf_hi(w.z); o[6] = bf_lo(w.w); o[7] = bf_hi(w.w); }
__device__ __forceinline__ void p2b_combine(Frame& F) {
    const bf16_t* PB = (const bf16_t*)(F.ws + WS_PB);
    const bf16_t* OP = (const bf16_t*)(F.ws + WS_OP); const float* ML = (const float*)(F.ws + WS_ML);
    bf16_t* Y = (bf16_t*)(F.ws + WS_Y);
    const int gw = F.vcu * NWAVES + F.wave, NGW = F.G * NWAVES, lane = F.lane, hh = lane >> 3;
    float cw[3][8];
#pragma unroll
    for (int t = 0; t < 3; ++t)
#pragma unroll
        for (int j = 0; j < 8; ++j) cw[t][j] = F.conv_w[t * 512 + 8 * lane + j];
    const int per = (M / 4 + NGW - 1) / NGW;
    for (int qd = gw * per; qd < (gw + 1) * per && qd < M / 4; ++qd) {
        const int tok0 = 4 * qd, s0 = tok0 & (SEQ - 1);
        u32x4 cu[6], cb[4], ow[4][3]; f32x2 ml[4][3];
#pragma unroll
        for (int t = 0; t < 6; ++t) { int ss = s0 + t - 1; ss = ss < 0 ? 0 : (ss > SEQ - 1 ? SEQ - 1 : ss); cu[t] = *(const u32x4*)(PB + (size_t)(tok0 - s0 + ss) * PBW + 512 + 8 * lane); }
#pragma unroll
        for (int k = 0; k < 4; ++k) { cb[k] = *(const u32x4*)(PB + (size_t)(tok0 + k) * PBW + 8 * lane);
#pragma unroll
            for (int p = 0; p < 3; ++p) { ml[k][p] = *(const f32x2*)(ML + (((size_t)p * M + tok0 + k) * 8 + hh) * 2); ow[k][p] = *(const u32x4*)(OP + ((size_t)p * M + tok0 + k) * 512 + 8 * lane); } }
        __builtin_amdgcn_sched_barrier(0);
        float uu[6][8];
#pragma unroll
        for (int t = 0; t < 6; ++t) { float b[8]; unpack8(cu[t], b); const int ss = s0 + t - 1; const float z = (ss >= 0 && ss < SEQ) ? 1.0f : 0.0f;
#pragma unroll
            for (int j = 0; j < 8; ++j) uu[t][j] = b[j] * z; }
#pragma unroll
        for (int k = 0; k < 4; ++k) {
            const float mm = fmaxf(fmaxf(ml[k][0].x, ml[k][1].x), ml[k][2].x);
            float wp[3], den = 0.f;
#pragma unroll
            for (int p = 0; p < 3; ++p) { wp[p] = __builtin_amdgcn_exp2f(ml[k][p].x - mm) * ml[k][p].y; den += wp[p]; }
            const float iden = 1.0f / den;
            float ya[8];
#pragma unroll
            for (int j = 0; j < 8; ++j) ya[j] = 0.f;
#pragma unroll
            for (int p = 0; p < 3; ++p) { float o[8]; unpack8(ow[k][p], o); const float c = wp[p] * iden;
#pragma unroll
                for (int j = 0; j < 8; ++j) ya[j] += c * o[j]; }
            float ssa = 0.f;
#pragma unroll
            for (int j = 0; j < 8; ++j) ssa += ya[j] * ya[j];
            float cbv[8]; unpack8(cb[k], cbv);
            float yc[8]; float ssc = 0.f;
#pragma unroll
            for (int j = 0; j < 8; ++j) { yc[j] = cbv[j] * (cw[0][j] * uu[k][j] + cw[1][j] * uu[k + 1][j] + cw[2][j] * uu[k + 2][j]); ssc += yc[j] * yc[j]; }
            const float ra = 1.0f / sqrtf(wave_sum(ssa) * (1.f / 512) + RMS_EPS), rc = 1.0f / sqrtf(wave_sum(ssc) * (1.f / 512) + RMS_EPS);
            u32x4 wa, wc4;
            wa.x = cvtpk(ya[0] * ra, ya[1] * ra); wa.y = cvtpk(ya[2] * ra, ya[3] * ra); wa.z = cvtpk(ya[4] * ra, ya[5] * ra); wa.w = cvtpk(ya[6] * ra, ya[7] * ra);
            wc4.x = cvtpk(yc[0] * rc, yc[1] * rc); wc4.y = cvtpk(yc[2] * rc, yc[3] * rc); wc4.z = cvtpk(yc[4] * rc, yc[5] * rc); wc4.w = cvtpk(yc[6] * rc, yc[7] * rc);
            *(u32x4*)(Y + (size_t)(tok0 + k) * DM + 8 * lane) = wc4;
            *(u32x4*)(Y + (size_t)(tok0 + k) * DM + 512 + 8 * lane) = wa;
        }
    }
}

__device__ __forceinline__ void p3b_router(Frame& F) {
    LAS float* gwP = (LAS float*)F.lds;
    for (int i = F.tid; i < DM * NE; i += NTHREADS) { const int k = i >> 4, e = i & 15; gwP[(((k >> 4) * 4 + ((k >> 2) & 3)) * 16 + e) * 4 + (k & 3)] = F.g_ffn[k] * F.w_router[i]; }
    __syncthreads();
    if (OVERLAP_CONV && F.G == 256 && F.wave >= 4)
        convert_items(F, NITEMS - N5_ITEMS - N6_ITEMS, NITEMS - N6_ITEMS, F.lds + F.wave * 16384, 0, 1 << 20, F.vcu * 4 + (F.wave - 4), F.G * 4);
    float* rstd2 = (float*)(F.ws + WS_RSTD2); float* aff = (float*)(F.ws + WS_AFF); int* inv = (int*)(F.ws + WS_INV);
    const int lane = F.lane, tk = lane & 15, q = lane >> 4;
    for (int grp = F.wave * F.G + F.vcu; grp < M / 16; grp += F.G * NWAVES) {
        const int t0 = grp * 16;
        const bf16_t* xrow = (const bf16_t*)(F.ws + WS_X1) + (size_t)(t0 + tk) * DM + 4 * q;
        f32x4 acc = {0.f, 0.f, 0.f, 0.f}; float ss = 0.f;
#pragma unroll 1
        for (int hf = 0; hf < 2; ++hf) {
            u32x2 vv[32];
#pragma unroll
            for (int c = 0; c < 32; ++c) vv[c] = *(const u32x2*)(xrow + 16 * (32 * hf + c));
            __builtin_amdgcn_sched_barrier(0);
#pragma unroll
            for (int c = 0; c < 32; ++c) {
                const f32x4 v = {bf_lo(vv[c].x), bf_hi(vv[c].x), bf_lo(vv[c].y), bf_hi(vv[c].y)};
                const f32x4 w = *(const LAS f32x4*)(gwP + (((32 * hf + c) * 4 + q) * 16 + tk) * 4);
                ss += (v.x * v.x + v.y * v.y) + (v.z * v.z + v.w * v.w);
                acc = __builtin_amdgcn_mfma_f32_16x16x4f32(v.x, w.x, acc, 0, 0, 0);
                acc = __builtin_amdgcn_mfma_f32_16x16x4f32(v.y, w.y, acc, 0, 0, 0);
                acc = __builtin_amdgcn_mfma_f32_16x16x4f32(v.z, w.z, acc, 0, 0, 0);
                acc = __builtin_amdgcn_mfma_f32_16x16x4f32(v.w, w.w, acc, 0, 0, 0);
            }
        }
        ss += __shfl_xor(ss, 16); ss += __shfl_xor(ss, 32);
        const float rstd = 1.0f / sqrtf(ss * (1.f / DM) + RMS_EPS);
        f32x4 lg;
#pragma unroll
        for (int r = 0; r < 4; ++r) lg[r] = acc[r] * __shfl(rstd, 4 * q + r);
        f32x4 mx = lg;
#pragma unroll
        for (int o = 1; o < 16; o <<= 1)
#pragma unroll
            for (int r = 0; r < 4; ++r) mx[r] = fmaxf(mx[r], __shfl_xor(mx[r], o));
        f32x4 ex, sm;
#pragma unroll
        for (int r = 0; r < 4; ++r) { ex[r] = expf(lg[r] - mx[r]); sm[r] = ex[r]; }
#pragma unroll
        for (int o = 1; o < 16; o <<= 1)
#pragma unroll
            for (int r = 0; r < 4; ++r) sm[r] += __shfl_xor(sm[r], o);
        f32x4 af;
#pragma unroll
        for (int r = 0; r < 4; ++r) af[r] = ex[r] / sm[r];
        const int b = t0 / SEQ, s0 = (t0 % SEQ) + 4 * q;
        *(f32x4*)(aff + ((size_t)b * NE + tk) * SEQ + s0) = af;
        *(int4*)(inv + (size_t)t0 * 16 + 4 * lane) = make_int4(-1, -1, -1, -1);
        if (q == 0) rstd2[t0 + tk] = rstd;
    }
    __syncthreads();
}

__device__ __forceinline__ void p4_topk(Frame& F) {
    const float* aff = (const float*)(F.ws + WS_AFF); int* arows = (int*)(F.ws + WS_AROWS); float* gatev = (float*)(F.ws + WS_GATEV); int* inv = (int*)(F.ws + WS_INV);
    float* rsg = (float*)(F.ws + WS_RSG); const float* rstd2 = (const float*)(F.ws + WS_RSTD2);
    volatile LAS int* cl = (volatile LAS int*)F.lds;
    const int lane = F.lane, w = F.wave;
    for (int task = F.vcu; task < BATCH * NE; task += F.G) {
        const int b = task / NE, e = task % NE, pm = e * 8 + b;
        unsigned v[4];
#pragma unroll
        for (int i = 0; i < 4; ++i) v[i] = __builtin_bit_cast(unsigned, aff[(size_t)task * SEQ + w * 256 + i * 64 + lane]);
        unsigned T = 0u;
        for (int bit = 30, rnd = 0; bit >= 0; bit -= 2, ++rnd) {
            const bool two = bit >= 1;
            const int lowb = two ? bit - 1 : bit;
            const unsigned c1 = T | (1u << lowb), c2 = T | (two ? (2u << lowb) : (1u << lowb)), c3 = T | (two ? (3u << lowb) : (1u << lowb));
            int n1 = 0, n2 = 0, n3 = 0;
#pragma unroll
            for (int i = 0; i < 4; ++i) { n1 += __builtin_popcountll(__ballot(v[i] >= c1)); n2 += __builtin_popcountll(__ballot(v[i] >= c2)); n3 += __builtin_popcountll(__ballot(v[i] >= c3)); }
            const int pb = (rnd & 1) * 32;
            if (lane == 0) { cl[pb + w] = n1; cl[pb + 8 + w] = n2; cl[pb + 16 + w] = n3; }
            __syncthreads();
            int t1 = 0, t2 = 0, t3 = 0;
#pragma unroll
            for (int j = 0; j < 8; ++j) { t1 += cl[pb + j]; t2 += cl[pb + 8 + j]; t3 += cl[pb + 16 + j]; }
            if (two) T = (t3 >= CAP) ? c3 : (t2 >= CAP) ? c2 : (t1 >= CAP) ? c1 : T;
            else T = (t1 >= CAP) ? c1 : T;
        }
        int gtc = 0, eqc = 0;
#pragma unroll
        for (int i = 0; i < 4; ++i) { gtc += __builtin_popcountll(__ballot(v[i] > T)); eqc += __builtin_popcountll(__ballot(v[i] == T)); }
        if (lane == 0) { cl[64 + w] = gtc; cl[72 + w] = eqc; }
        __syncthreads();
        int cgt = 0;
#pragma unroll
        for (int j = 0; j < 8; ++j) cgt += cl[64 + j];
        const int need = CAP - cgt;
        int base = 0, eqbase = 0;
        for (int j = 0; j < w; ++j) { const int g_ = cl[64 + j], q_ = cl[72 + j]; int take = need - eqbase; take = take < 0 ? 0 : (take > q_ ? q_ : take); base += g_ + take; eqbase += q_; }
        const unsigned long long lt = (1ull << lane) - 1ull;
#pragma unroll
        for (int i = 0; i < 4; ++i) {
            const bool eq = (v[i] == T);
            const unsigned long long meq = __ballot(eq);
            const int req = eqbase + __builtin_popcountll(meq & lt);
            const bool sel = (v[i] > T) || (eq && req < need);
            const unsigned long long ms = __ballot(sel);
            const int slot = base + __builtin_popcountll(ms & lt);
            if (sel) {
                const int sidx = w * 256 + i * 64 + lane;
                arows[pm * 256 + slot] = b * SEQ + sidx;
                gatev[pm * 256 + slot] = __builtin_bit_cast(float, v[i]);
                rsg[pm * 256 + slot] = rstd2[b * SEQ + sidx] * (EXP_FP8 ? W8_INV : 1.0f);
                inv[(size_t)(b * SEQ + sidx) * 16 + e] = slot;
            }
            base += __builtin_popcountll(ms); eqbase += __builtin_popcountll(meq);
        }
        __syncthreads();
    }
}

__device__ __forceinline__ void p7_final(Frame& F) {
    const bf16_t* CN = (const bf16_t*)(F.ws + WS_CN); const int* inv = (const int*)(F.ws + WS_INV);
    const int gw = F.vcu * NWAVES + F.wave, NGW = F.G * NWAVES, lane = F.lane, j = lane & 15, grp = lane >> 4;
    const int per = (M / 4 + NGW - 1) / NGW;
    for (int qd = gw * per; qd < (gw + 1) * per && qd < M / 4; ++qd) {
        const int tok = qd * 4 + grp, b = tok / SEQ;
        float* xr = F.out + (size_t)tok * DM + 8 * j;
        const int myinv = inv[(size_t)tok * 16 + j];
        f32x4 v[8][2];
        { const bf16_t* x1r = (const bf16_t*)(F.ws + WS_X1) + (size_t)tok * DM + 8 * j; u32x4 xw[8];
#pragma unroll
          for (int i = 0; i < 8; ++i) xw[i] = *(const u32x4*)(x1r + 128 * i);
          __builtin_amdgcn_sched_barrier(0);
#pragma unroll
          for (int i = 0; i < 8; ++i) { v[i][0] = (f32x4){bf_lo(xw[i].x), bf_hi(xw[i].x), bf_lo(xw[i].y), bf_hi(xw[i].y)}; v[i][1] = (f32x4){bf_lo(xw[i].z), bf_hi(xw[i].z), bf_lo(xw[i].w), bf_hi(xw[i].w)}; } }
        unsigned m16 = (unsigned)((__ballot(myinv >= 0) >> (16 * grp)) & 0xffffull);
        while (__any(m16 != 0u)) {
            const bool h0 = m16 != 0u; const int e0 = h0 ? __builtin_ctz(m16) : 0; m16 &= m16 - 1u;
            const int s0 = __shfl(myinv, 16 * grp + e0);
            if (h0) {
                if (EXP_FP8) {
                    const unsigned char* r0 = (const unsigned char*)CN + ((size_t)(e0 * 8 + b) * 256 + s0) * DM + 8 * j;
                    u32x2 w0[8];
#pragma unroll
                    for (int i = 0; i < 8; ++i) w0[i] = *(const u32x2*)(r0 + 128 * i);
                    __builtin_amdgcn_sched_barrier(0);
#pragma unroll
                    for (int i = 0; i < 8; ++i) {
                        const f32x2 a0 = __builtin_amdgcn_cvt_pk_f32_fp8((int)w0[i].x, false), a1 = __builtin_amdgcn_cvt_pk_f32_fp8((int)w0[i].x, true);
                        const f32x2 b0 = __builtin_amdgcn_cvt_pk_f32_fp8((int)w0[i].y, false), b1 = __builtin_amdgcn_cvt_pk_f32_fp8((int)w0[i].y, true);
                        v[i][0].x += a0.x * CN_INV; v[i][0].y += a0.y * CN_INV; v[i][0].z += a1.x * CN_INV; v[i][0].w += a1.y * CN_INV;
                        v[i][1].x += b0.x * CN_INV; v[i][1].y += b0.y * CN_INV; v[i][1].z += b1.x * CN_INV; v[i][1].w += b1.y * CN_INV; }
                } else {
                    const bf16_t* r0 = CN + ((size_t)(e0 * 8 + b) * 256 + s0) * DM + 8 * j;
                    u32x4 w0[8];
#pragma unroll
                    for (int i = 0; i < 8; ++i) w0[i] = *(const u32x4*)(r0 + 128 * i);
                    __builtin_amdgcn_sched_barrier(0);
#pragma unroll
                    for (int i = 0; i < 8; ++i) { v[i][0].x += bf_lo(w0[i].x); v[i][0].y += bf_hi(w0[i].x); v[i][0].z += bf_lo(w0[i].y); v[i][0].w += bf_hi(w0[i].y);
                        v[i][1].x += bf_lo(w0[i].z); v[i][1].y += bf_hi(w0[i].z); v[i][1].z += bf_lo(w0[i].w); v[i][1].w += bf_hi(w0[i].w); }
                }
            }
        }
        float ss = 0.f;
#pragma unroll
        for (int i = 0; i < 8; ++i)
#pragma unroll
            for (int c = 0; c < 2; ++c) ss += (v[i][c].x * v[i][c].x + v[i][c].y * v[i][c].y) + (v[i][c].z * v[i][c].z + v[i][c].w * v[i][c].w);
        ss += __shfl_xor(ss, 1); ss += __shfl_xor(ss, 2); ss += __shfl_xor(ss, 4); ss += __shfl_xor(ss, 8);
        const float rstd = 1.0f / sqrtf(ss * (1.f / DM) + RMS_EPS);
        int zo = 0; asm volatile("" : "+v"(zo));
        f32x4 gq[8][2];
#pragma unroll
        for (int i = 0; i < 8; ++i) { gq[i][0] = *(const f32x4*)(F.g_final + zo + 8 * j + 128 * i); gq[i][1] = *(const f32x4*)(F.g_final + zo + 8 * j + 128 * i + 4); }
        __builtin_amdgcn_sched_barrier(0);
#pragma unroll
        for (int i = 0; i < 8; ++i) { *(f32x4*)(xr + 128 * i) = v[i][0] * rstd * gq[i][0]; *(f32x4*)(xr + 128 * i + 4) = v[i][1] * rstd * gq[i][1]; }
    }
}

struct Args { const void* in[14]; float* out; unsigned char* ws; int ph_lo, ph_hi; };
__global__ void __launch_bounds__(NTHREADS, 2) fwd_kernel(Args args) {
    extern __shared__ __attribute__((aligned(16))) unsigned char lds[];
    Frame F;
    F.lds = (LAS unsigned char*)lds;
    F.tid = threadIdx.x; F.lane = F.tid & 63; F.wave = __builtin_amdgcn_readfirstlane(F.tid >> 6);
    F.G = gridDim.x; { const int bx = blockIdx.x; F.vcu = (F.G % 8 == 0) ? (bx % 8) * (F.G / 8) + bx / 8 : bx; }
    F.x = (const float*)args.in[0]; F.pos = (const int*)args.in[1]; F.g_mix = (const float*)args.in[2]; F.w_in = (const float*)args.in[3];
    F.conv_w = (const float*)args.in[4]; F.g_conv = (const float*)args.in[5]; F.g_attn = (const float*)args.in[6]; F.w_out = (const float*)args.in[7];
    F.g_ffn = (const float*)args.in[8]; F.w_router = (const float*)args.in[9]; F.w_gate = (const float*)args.in[10]; F.w_up = (const float*)args.in[11];
    F.w_down = (const float*)args.in[12]; F.g_final = (const float*)args.in[13];
    F.out = args.out; F.ws = args.ws;
    volatile LAS unsigned* MISC = (volatile LAS unsigned*)(F.lds + MISC_OFF);
    for (int u = F.tid; u < (LDS_BYTES - LDSCTL_OFF) / 4; u += NTHREADS) ((LAS unsigned*)(F.lds + LDSCTL_OFF))[u] = 0u;
    __syncthreads();
    const int lo = args.ph_lo, hi = args.ph_hi;
    XcdBarrier bar; bar.bar = (unsigned*)(F.ws + WS_CTL) + CW_BAR; bar.x = 0; bar.st = nullptr;
    if (hi - lo > 1) bar = xcd_barrier_post((unsigned*)(F.ws + WS_CTL) + CW_BAR, MISC + 8);
#ifndef PH_MASK
#define PH_MASK 0x3ff
#endif
#define IN(k) (((PH_MASK >> (k)) & 1) && lo <= (k) && (k) < hi)
#define SEAM(k) do { if (IN(k) && IN((k) + 1)) xcd_barrier(bar); } while (0)
    bf16_t* XN = (bf16_t*)(F.ws + WS_XN);
    if (IN(0)) { p0_prologue(F); SEAM(0); }
    if (IN(1)) {
        const bool split = OVERLAP_CONV && NG1 > 0 && F.G == 256;
        if (!split || (int)blockIdx.x < NG1) {
            Gemm g{XN, (const bf16_t*)(F.ws + WS_WIN), nullptr, DM}; DenseOrder S; S.init(M, PW, split ? NG1 : F.G, (int)blockIdx.x);
            EpiQKV E{(bf16_t*)(F.ws + WS_PB), (bf16_t*)(F.ws + WS_QH), (const float*)(F.ws + WS_ROPE)};
            gemm_phase_fast<false>(F.lds, g, S, E);
        } else {
            convert_items(F, I_IN, I_IN + N1_ITEMS, F.lds + F.wave * 16384, 0, 1 << 20, ((int)blockIdx.x - NG1) * NWAVES + F.wave, (F.G - NG1) * NWAVES);
        }
        SEAM(1);
    }
    if (IN(2)) {
        if (OVERLAP_CONV) {
            const int c0 = I_IN + ((NG1 > 0 && F.G == 256) ? N1_ITEMS : 0);
            if (F.wave < ATT_WAVES) p2a_attention_w<ATT_WAVES>(F);
            else convert_items(F, c0, NITEMS - ((F.G == 256) ? N5_ITEMS + N6_ITEMS : 0), F.lds + F.wave * 16384, 0, 1 << 20, F.vcu * (NWAVES - ATT_WAVES) + (F.wave - ATT_WAVES), F.G * (NWAVES - ATT_WAVES));
        } else p2a_attention(F);
        SEAM(2); }
    if (IN(3)) { p2b_combine(F); SEAM(3); }
    if (IN(4)) {
        Gemm g{(const bf16_t*)(F.ws + WS_Y), (const bf16_t*)(F.ws + WS_WOUT), nullptr, DM}; DenseOrder S; S.init(M, DM, F.G, (int)blockIdx.x);
        EpiRes E{XN, (const float*)(F.ws + WS_IRSTD1), (bf16_t*)(F.ws + WS_X1), (bf16_t*)(F.ws + WS_XN2)};
        gemm_phase_fast<false>(F.lds, g, S, E); SEAM(4);
    }
    if (IN(5)) {
        p3b_router(F); SEAM(5); }
    if (IN(6)) {
        if (OVERLAP_CONV && F.G == 256 && F.vcu >= BATCH * NE)
            convert_items(F, NITEMS - N6_ITEMS, NITEMS, F.lds + F.wave * 16384, 0, 1 << 20, (F.vcu - BATCH * NE) * NWAVES + F.wave, (F.G - BATCH * NE) * NWAVES);
        p4_topk(F); SEAM(6); }
    if (IN(7)) {
        Gemm g{(const bf16_t*)(F.ws + WS_XN2), (const bf16_t*)(F.ws + WS_WGU), (const int*)(F.ws + WS_AROWS), EXP_FP8 ? DM / 2 : DM}; ExpertOrder S; S.init(16, F.G, (int)blockIdx.x);
        EpiSwiGLU E{(bf16_t*)(F.ws + WS_H), (const float*)(F.ws + WS_RSG)};
        { LAS int* al = (LAS int*)(F.lds + AROWS_LDS_OFF); Unit uu;
          for (int i = 0; i < 8 && S.next(i, uu); ++i) if (F.tid < 256) al[i * 256 + F.tid] = g.arows[uu.pm * 256 + F.tid];
          __syncthreads(); g.arows_l = al; }
        gemm_phase_fast<EXP_FP8 != 0>(F.lds, g, S, E); SEAM(7);
    }
    if (IN(8)) {
        Gemm g{(const bf16_t*)(F.ws + WS_H), (const bf16_t*)(F.ws + WS_WD), nullptr, EXP_FP8 ? DFF / 2 : DFF}; ExpertOrder S; S.init(4, F.G, (int)blockIdx.x);
        EpiContrib E{(bf16_t*)(F.ws + WS_CN), (const float*)(F.ws + WS_GATEV)};
        gemm_phase_fast<EXP_FP8 != 0>(F.lds, g, S, E); SEAM(8);
    }
    if (IN(9)) { p7_final(F); }
#undef IN
#undef SEAM
}

extern "C" void kernel_launch(void* const* d_in, const int* in_sizes, int n_in, void* d_out, int out_size, void* d_ws, size_t ws_size, hipStream_t stream) {
    static int grid = 0;
    if (grid == 0) {
        if (n_in != 14 || out_size != M * DM || ws_size < WS_END) { fprintf(stderr, "kernel_launch: unexpected problem (n_in %d out %d ws %zu)\n", n_in, out_size, ws_size); grid = -1; return; }
        int dev = 0, cus = 0, per_cu = 0;
        if (hipGetDevice(&dev) != hipSuccess || hipDeviceGetAttribute(&cus, hipDeviceAttributeMultiprocessorCount, dev) != hipSuccess) { grid = -1; return; }
        if (hipFuncSetAttribute((const void*)fwd_kernel, hipFuncAttributeMaxDynamicSharedMemorySize, LDS_BYTES) != hipSuccess) { fprintf(stderr, "kernel_launch: hipFuncSetAttribute failed\n"); grid = -1; return; }
        if (hipOccupancyMaxActiveBlocksPerMultiprocessor(&per_cu, (const void*)fwd_kernel, NTHREADS, LDS_BYTES) != hipSuccess || per_cu < 1) { fprintf(stderr, "kernel_launch: occupancy query says %d\n", per_cu); per_cu = 1; }
        (void)hipGetLastError();
        grid = cus;
    }
    if (grid < 0) return;
    (void)hipMemsetAsync((char*)d_ws + WS_CTL, 0, CTL_ZERO_BYTES, stream);
    Args a{};
    for (int i = 0; i < 14; ++i) a.in[i] = d_in[i];
    a.out = (float*)d_out; a.ws = (unsigned char*)d_ws;
    if (MK_N_LAUNCHES == 1) {
        a.ph_lo = 0; a.ph_hi = N_PHASES;
        hipLaunchKernelGGL(fwd_kernel, dim3(grid), dim3(NTHREADS), LDS_BYTES, stream, a);
    } else {
        for (int p = 0; p < N_PHASES; ++p) { a.ph_lo = p; a.ph_hi = p + 1; hipLaunchKernelGGL(fwd_kernel, dim3(grid), dim3(NTHREADS), LDS_BYTES, stream, a); }
    }
}
```

```cpp
#include <hip/hip_runtime.h>
#include <cstdio>
#include <cstdint>

#define GAS __attribute__((address_space(1)))
#define LAS __attribute__((address_space(3)))
typedef unsigned short bf16_t;
typedef short bf16x8 __attribute__((ext_vector_type(8)));
typedef float f32x4 __attribute__((ext_vector_type(4)));
typedef float f32x2 __attribute__((ext_vector_type(2)));
typedef float f32x16 __attribute__((ext_vector_type(16)));
typedef unsigned u32x4 __attribute__((ext_vector_type(4)));
typedef unsigned u32x2 __attribute__((ext_vector_type(2)));
typedef __bf16 bf16x2_t __attribute__((ext_vector_type(2)));
typedef int v4i_t __attribute__((ext_vector_type(4)));
typedef int v8i_t __attribute__((ext_vector_type(8)));

#ifndef NG1
#define NG1 192
#endif
#ifndef N1_ITEMS
#define N1_ITEMS 10000
#endif
#ifndef ATT_WAVES
#define ATT_WAVES 6
#endif
#ifndef N5_ITEMS
#define N5_ITEMS 4000
#endif
#ifndef N6_ITEMS
#define N6_ITEMS 1500
#endif
#ifndef SWIGLU_LEAN
#define SWIGLU_LEAN 1
#endif
#ifndef ATT_ROWSTORE
#define ATT_ROWSTORE 1
#endif
#ifndef OVERLAP_CONV
#define OVERLAP_CONV 1
#endif
#ifndef EXP_FP8
#define EXP_FP8 1
#endif
#ifndef MK_N_LAUNCHES
#define MK_N_LAUNCHES 1
#endif

constexpr int BATCH = 8, SEQ = 2048, DM = 1024, M = BATCH * SEQ, PW = 3072, NH = 8, HD = 64, NE = 16, CAP = 256, DFF = 2048;
constexpr int NWAVES = 8, NTHREADS = 512;
constexpr float RMS_EPS = 1e-6f;
constexpr float QSCALE = 0.125f * 1.4426950408889634f;
constexpr int N_PHASES = 10;

constexpr size_t MiB = 1u << 20;
constexpr size_t WS_CTL = 0, CTL_ZERO_BYTES = 64 * 1024;
constexpr size_t WS_RSTD2 = 1 * MiB;
constexpr size_t WS_IRSTD1 = 1 * MiB + 512 * 1024;
constexpr size_t WS_XN2 = 336 * MiB;
constexpr size_t WS_ROPE = 2 * MiB;
constexpr size_t WS_AFF = 3 * MiB;
constexpr size_t WS_AROWS = 4 * MiB;
constexpr size_t WS_GATEV = 4 * MiB + 256 * 1024;
constexpr size_t WS_RSG = 4 * MiB + 512 * 1024;
constexpr size_t WS_INV = 5 * MiB;
constexpr size_t WS_WIN = 8 * MiB;
constexpr size_t WS_WOUT = 14 * MiB;
constexpr size_t WS_WGU = 16 * MiB;
constexpr size_t WS_WD = 144 * MiB;
constexpr size_t WS_XN = 208 * MiB;
constexpr size_t WS_Y = 240 * MiB;
constexpr size_t WS_CN = 208 * MiB;
constexpr size_t WS_PB = 272 * MiB;
constexpr size_t WS_QH = 320 * MiB, WS_KH = 336 * MiB, WS_VH = 352 * MiB;
constexpr int PBW = 1024;
constexpr size_t WS_OP = 368 * MiB;
constexpr size_t WS_ML = 416 * MiB;
constexpr size_t WS_H = 272 * MiB;
constexpr size_t WS_X1 = 384 * MiB;
constexpr size_t WS_END = 420 * MiB;
constexpr int CW_BAR = 4096;

constexpr int RING_BYTES = 131072;
constexpr int LDSCTL_OFF = RING_BYTES, MISC_OFF = LDSCTL_OFF + 320;
constexpr int LDS_BYTES = 147456;
constexpr int AROWS_LDS_OFF = MISC_OFF + 128;

#define LDS_WAIT() asm volatile("s_waitcnt lgkmcnt(0)" ::: "memory")
#define VM_WAIT() asm volatile("s_waitcnt vmcnt(0)" ::: "memory")
#define RLX_AGENT __ATOMIC_RELAXED, __HIP_MEMORY_SCOPE_AGENT
__device__ __forceinline__ unsigned cvtpk(float lo, float hi) { f32x2 v = {lo, hi}; bf16x2_t b = __builtin_convertvector(v, bf16x2_t); return __builtin_bit_cast(unsigned, b); }
__device__ __forceinline__ unsigned cvt4_fp8(float a, float b, float c, float d) { int w = 0; w = __builtin_amdgcn_cvt_pk_fp8_f32(a, b, w, false); w = __builtin_amdgcn_cvt_pk_fp8_f32(c, d, w, true); return (unsigned)w; }
__device__ __forceinline__ v8i_t cat8(bf16x8 a, bf16x8 b) { const v4i_t x = __builtin_bit_cast(v4i_t, a), y = __builtin_bit_cast(v4i_t, b); return __builtin_shufflevector(x, y, 0, 1, 2, 3, 4, 5, 6, 7); }
constexpr float W8_SCALE = 32.0f, W8_INV = 1.0f / 32.0f;
constexpr float CN_SCALE = 16.0f, CN_INV = 1.0f / 16.0f;
__device__ __forceinline__ float bf_lo(unsigned w) { return __builtin_bit_cast(float, w << 16); }
__device__ __forceinline__ float bf_hi(unsigned w) { return __builtin_bit_cast(float, w & 0xffff0000u); }
__device__ __forceinline__ float wave_sum(float v) {
#pragma unroll
    for (int o = 1; o < 64; o <<= 1) v += __shfl_xor(v, o);
    return v;
}

#define XB_TMO      128
#define XB_XCNT(j)  (256  + 64 * (j))
#define XB_XSUB(j)  (1280 + 64 * (j))
#define XB_XGEN(j)  (2304 + 64 * (j))
#define XB_TOP      3328
#define XB_TOPGEN   3392
#define XCD_BAR_WORDS 3456
#define XB_SPIN_CAP (1u << 18)
__device__ __forceinline__ unsigned xb_ld(unsigned* p)              { return __hip_atomic_load(p, __ATOMIC_RELAXED, __HIP_MEMORY_SCOPE_AGENT); }
__device__ __forceinline__ unsigned xb_add(unsigned* p, unsigned v) { return __hip_atomic_fetch_add(p, v, __ATOMIC_RELAXED, __HIP_MEMORY_SCOPE_AGENT); }
__device__ __forceinline__ unsigned xb_xcc_id() { return (unsigned)__builtin_amdgcn_s_getreg((3 << 11) | 20) & 0xFu; }
#define XB_SPIN(cond, bar) do { unsigned _sp = 0; while (cond) { __builtin_amdgcn_s_sleep(1); \
    if ((++_sp & 255u) == 0u) { if (xb_ld(&(bar)[XB_TMO])) break; if (_sp > XB_SPIN_CAP) { atomicAdd(&(bar)[XB_TMO], 1u); break; } } } } while (0)
struct XcdBarrier { unsigned* bar; unsigned x; volatile LAS unsigned* st; };
__device__ __forceinline__ XcdBarrier xcd_barrier_post(unsigned* bar, volatile LAS unsigned* st) {
    XcdBarrier b; b.bar = bar; b.x = xb_xcc_id(); b.st = st;
    if (threadIdx.x == 0) (void)xb_add(&bar[XB_XCNT(b.x)], 1u);
    return b;
}
__device__ __forceinline__ void xcd_barrier_complete(unsigned* bar, unsigned x, unsigned& nloc, unsigned& nx) {
    const unsigned G = gridDim.x * gridDim.y * gridDim.z;
    unsigned sum, cnt, mine, sp = 0u;
    for (;;) {
        sum = 0u; cnt = 0u; mine = 0u;
#pragma unroll
        for (unsigned j = 0; j < 16; ++j) { const unsigned c = xb_ld(&bar[XB_XCNT(j)]); sum += c; cnt += (c > 0u) ? 1u : 0u; mine = (j == x) ? c : mine; }
        if (sum == G) break;
        __builtin_amdgcn_s_sleep(1);
        if ((++sp & 255u) == 0u) { if (xb_ld(&bar[XB_TMO])) break; if (sp > XB_SPIN_CAP) { atomicAdd(&bar[XB_TMO], 1u); break; } }
    }
    nloc = mine > 0u ? mine : 1u; nx = cnt > 0u ? cnt : 1u;
}
__device__ __forceinline__ void xcd_barrier(const XcdBarrier& b) {
    asm volatile("s_waitcnt vmcnt(0)" ::: "memory");
    __syncthreads();
    if (threadIdx.x == 0) {
        unsigned* bar = b.bar;
        __builtin_amdgcn_s_waitcnt(0);
        unsigned nloc = b.st[0], nx = b.st[1];
        if (nloc == 0u) { xcd_barrier_complete(bar, b.x, nloc, nx); b.st[0] = nloc; b.st[1] = nx; }
        const unsigned old = xb_add(&bar[XB_XSUB(b.x)], 1u);
        const unsigned gen = old / nloc;
        if (old + 1u == (gen + 1u) * nloc) {
            __builtin_amdgcn_fence(__ATOMIC_RELEASE, "agent");
            asm volatile("s_waitcnt vmcnt(0)" ::: "memory");
            const unsigned og = xb_add(&bar[XB_TOP], 1u);
            const unsigned tg = og / nx;
            if (og + 1u == (tg + 1u) * nx) xb_add(&bar[XB_TOPGEN], 1u);
            else XB_SPIN(xb_ld(&bar[XB_TOPGEN]) == tg, bar);
            __builtin_amdgcn_fence(__ATOMIC_ACQUIRE, "agent");
            xb_add(&bar[XB_XGEN(b.x)], 1u);
            asm volatile("s_waitcnt vmcnt(0)" ::: "memory");
        } else {
            XB_SPIN(xb_ld(&bar[XB_XGEN(b.x)]) == gen, bar);
            __builtin_amdgcn_fence(__ATOMIC_ACQUIRE, "agent");
            asm volatile("s_waitcnt vmcnt(0)" ::: "memory");
        }
    }
    __syncthreads();
}

struct Frame {
    LAS unsigned char* lds;
    int tid, lane, wave, vcu, G;
    const float* x; const int* pos; const float *g_mix, *w_in, *conv_w, *g_conv, *g_attn, *w_out, *g_ffn, *w_router, *w_gate, *w_up, *w_down, *g_final;
    float* out; unsigned char* ws;
};

struct Unit { int pm, pb, pc; };
struct Gemm { const bf16_t* A; const bf16_t* Bt; const int* arows; int K; const LAS int* arows_l = nullptr; };

struct DenseOrder {
    int nM, nN, nwg, G, c;
    __device__ __forceinline__ void init(int Mr, int N, int G_, int c_) { nM = Mr / 256; nN = N / 256; nwg = nM * nN; G = G_; c = c_; }
    __device__ __forceinline__ bool next(int i, Unit& u) const {
        const long L = (long)i * G + c; if (L >= nwg) return false;
        int wgid = (int)L; { const int q = nwg / 8, r = nwg % 8, xcd = wgid % 8, off = wgid / 8; wgid = (xcd < r ? xcd * (q + 1) : r * (q + 1) + (xcd - r) * q) + off; }
        const int nig = 8 * nN, gid = wgid / nig, fm = gid * 8, gsz = (nM - fm) < 8 ? (nM - fm) : 8;
        u.pm = fm + ((wgid % nig) % gsz); u.pb = (wgid % nig) / gsz; u.pc = u.pb; return true;
    }
};
struct Gemm1Order {
    int x, l;
    __device__ __forceinline__ void init(int bx) { x = bx & 7; l = bx >> 3; }
    __device__ __forceinline__ bool next(int i, Unit& u) const { if (i >= 4) return false; u.pm = 8 * x + 4 * (i & 1) + (l & 3); u.pb = 6 * (i >> 1) + (l >> 2); u.pc = u.pb; return true; }
};
struct ExpertOrder {
    int NB, nunits, G, c;
    __device__ __forceinline__ void init(int NB_, int G_, int c_) { NB = NB_; nunits = NE * NB_ * BATCH; G = G_; c = c_; }
    __device__ __forceinline__ bool next(int i, Unit& u) const {
        int uid;
        if ((G & 7) == 0) uid = (i * 8 + (c & 7)) * (G >> 3) + (c >> 3); else uid = i * G + c;
        if (uid >= nunits) return false;
        const int b = uid & 7, q = uid >> 3, n = q % NB, e = q / NB;
        u.pm = e * 8 + b; u.pb = e * NB + n; u.pc = n; return true;
    }
};

__device__ __forceinline__ int perm32(int rho) { const int n = rho >> 4, i = rho & 15; return 8 * (i >> 2) + 4 * n + (i & 3); }

constexpr int BK = 64, HTB = 128 * BK * 2;
__host__ __device__ __forceinline__ int lds_byte(int r, int c) { const int st = (r >> 4) * 2 + (c >> 5), rr = r & 15, cc = c & 31, ob = rr * 64 + cc * 2; return st * 1024 + (ob ^ (((ob >> 9) & 1) << 5)); }
__host__ __device__ __forceinline__ void stage_rc(int b, int& R, int& C) { const int st = b / 1024, sb = b % 1024, swz = sb ^ (((sb >> 9) & 1) << 5); R = (st >> 1) * 16 + swz / 64; C = (st & 1) * 32 + (swz % 64) / 2; }

__device__ __forceinline__ void mfma8_inplace(f32x4& c, const v8i_t a, const v8i_t b, const int one8) {
    asm volatile("v_mfma_scale_f32_16x16x128_f8f6f4 %0, %1, %2, %0, %3, %3 op_sel_hi:[0,0,0]" : "+v"(c) : "v"(a), "v"(b), "v"(one8));
}
template <bool F8, class Epi, class Sched>
__device__ __forceinline__ void gemm_phase_fast(LAS unsigned char* lds, const Gemm g, const Sched& S, const Epi& E) {
    const int tid = threadIdx.x, wid = __builtin_amdgcn_readfirstlane(tid >> 6), lane = tid & 63, wr = wid >> 2, wc = wid & 3, fr = lane & 15, fq = lane >> 4;
    const int K = g.K, nt = K / BK;
    int RA[2], CA[2]; unsigned voffB[2];
#pragma unroll
    for (int i = 0; i < 2; ++i) { int R, C; stage_rc(tid * 16 + i * 8192, R, C); RA[i] = R; CA[i] = C; const int Rb = (R & ~31) + perm32(R & 31); voffB[i] = (unsigned)(Rb * K + C) * 2u; }
    const size_t kstep = (size_t)(BK * 2);
    const size_t hstep = (size_t)128 * K * 2;
    const size_t tstep = 2 * hstep;
    const unsigned ldsw = (unsigned)wid * 1024u;
    const int aoff = lds_byte(wr * 64 + fr, fq * 8), boff = lds_byte(wc * 32 + fr, fq * 8);
#define PG8_SA(b, h) (((b) * 2 + (h)) * HTB)
#define PG8_SB(b, h) ((4 + (b) * 2 + (h)) * HTB)
#define PG8_STAGE(bufoff, gbase, voff) do { _Pragma("unroll") for (int _i = 0; _i < 2; ++_i) \
        __builtin_amdgcn_global_load_lds((const unsigned*)((const char*)(gbase) + (voff)[_i]), (LAS unsigned*)(lds + (bufoff) + ldsw + _i * 8192), 16, 0, 0); } while (0)
#define PG8_LDA(dst, b, h) do { _Pragma("unroll") for (int m = 0; m < 4; ++m) _Pragma("unroll") for (int k = 0; k < 2; ++k) dst[m][k] = *(const LAS bf16x8*)(lds + PG8_SA(b, h) + aoff + m * 2048 + k * 1024); } while (0)
#define PG8_LDB(dst, b, h) do { _Pragma("unroll") for (int n = 0; n < 2; ++n) _Pragma("unroll") for (int k = 0; k < 2; ++k) dst[n][k] = *(const LAS bf16x8*)(lds + PG8_SB(b, h) + boff + n * 2048 + k * 1024); } while (0)
#define PG8_MMA(ai, bj, At, Bt) do { __builtin_amdgcn_s_setprio(1); _Pragma("unroll") for (int m = 0; m < 4; ++m) _Pragma("unroll") for (int n = 0; n < 2; ++n) { \
        if constexpr (F8) mfma8_inplace(acc[ai][bj][m][n], cat8(Bt[n][0], Bt[n][1]), cat8(At[m][0], At[m][1]), one8); \
        else { _Pragma("unroll") for (int k = 0; k < 2; ++k) acc[ai][bj][m][n] = __builtin_amdgcn_mfma_f32_16x16x32_bf16(Bt[n][k], At[m][k], acc[ai][bj][m][n], 0, 0, 0); } } \
        __builtin_amdgcn_s_setprio(0); } while (0)
#define PG8_WAIT_V(n) asm volatile("s_waitcnt vmcnt(" #n ")" ::: "memory")
#define PG8_WAIT_L(n) asm volatile("s_waitcnt lgkmcnt(" #n ")" ::: "memory")
#define PG8_BAR __builtin_amdgcn_s_barrier()
#define PG8_SCHED __builtin_amdgcn_sched_barrier(0)
#define PG8_AOFFS(dst, u, uidx) do { _Pragma("unroll") for (int _h = 0; _h < 2; ++_h) _Pragma("unroll") for (int _i = 0; _i < 2; ++_i) { const int _r = (u).pm * 256 + _h * 128 + RA[_i]; \
        const int _row = g.arows_l ? g.arows_l[(uidx) * 256 + _h * 128 + RA[_i]] : (g.arows ? g.arows[_r] : _r); dst[_h][_i] = ((unsigned)_row * (unsigned)K + (unsigned)CA[_i]) * 2u; } } while (0)
    Unit cur, nxt; int ui = 0;
    if (!S.next(0, cur)) return;
    int one8 = 0x7f7f7f7f; asm volatile("" : "+v"(one8));
    f32x4 acc[2][2][4][2];
#pragma unroll
    for (int a = 0; a < 2; ++a)
#pragma unroll
        for (int b = 0; b < 2; ++b)
#pragma unroll
            for (int m = 0; m < 4; ++m)
#pragma unroll
                for (int n = 0; n < 2; ++n) acc[a][b][m][n] = (f32x4){0.f, 0.f, 0.f, 0.f};
    bf16x8 At[4][2], B0[2][2], B1[2][2];
    unsigned vA[2][2], vN[2][2];
    PG8_AOFFS(vA, cur, 0);
    const char* const gA = (const char*)g.A;
    const char* cB = (const char*)g.Bt + (size_t)cur.pb * tstep;
    PG8_STAGE(PG8_SB(0, 0), cB, voffB); PG8_STAGE(PG8_SB(0, 1), cB + hstep, voffB); PG8_STAGE(PG8_SA(0, 0), gA, vA[0]); PG8_STAGE(PG8_SA(0, 1), gA, vA[1]);
    if (wr == 1) PG8_BAR;
    PG8_WAIT_V(2); PG8_BAR;
    PG8_STAGE(PG8_SB(1, 0), cB + kstep, voffB); PG8_STAGE(PG8_SA(1, 0), gA + kstep, vA[0]); PG8_STAGE(PG8_SB(1, 1), cB + hstep + kstep, voffB);
    PG8_WAIT_V(6); PG8_BAR;
    for (;;) {
        const bool has_next = S.next(ui + 1, nxt);
        if (has_next) { PG8_AOFFS(vN, nxt, ui + 1); } else {
#pragma unroll
            for (int h = 0; h < 2; ++h)
#pragma unroll
                for (int i = 0; i < 2; ++i) vN[h][i] = vA[h][i]; }
        const char* nB = has_next ? (const char*)g.Bt + (size_t)nxt.pb * tstep : cB;
        for (int t = 0; t < nt; t += 2) {
            const bool last = (t == nt - 2);
            const char* a1 = gA + (size_t)(t + 1) * kstep;
            const char* a2 = last ? gA : gA + (size_t)(t + 2) * kstep; const char* b2 = last ? nB : cB + (size_t)(t + 2) * kstep;
            const char* a3 = a2 + kstep; const char* b3 = b2 + kstep;
            unsigned v2[2][2];
#pragma unroll
            for (int h = 0; h < 2; ++h)
#pragma unroll
                for (int i = 0; i < 2; ++i) v2[h][i] = last ? vN[h][i] : vA[h][i];
            PG8_LDB(B0, 0, 0); PG8_LDB(B1, 0, 1); PG8_SCHED; PG8_LDA(At, 0, 0); PG8_STAGE(PG8_SA(1, 1), a1, vA[1]);
            PG8_WAIT_V(8); PG8_WAIT_L(0); PG8_BAR; PG8_MMA(0, 0, At, B0); PG8_MMA(0, 1, At, B1); PG8_BAR; PG8_SCHED;
            PG8_LDA(At, 0, 1); PG8_STAGE(PG8_SB(0, 0), b2, voffB); PG8_STAGE(PG8_SB(0, 1), b2 + hstep, voffB); PG8_STAGE(PG8_SA(0, 0), a2, v2[0]);
            PG8_WAIT_V(8); PG8_WAIT_L(0); PG8_BAR; PG8_MMA(1, 0, At, B0); PG8_MMA(1, 1, At, B1); PG8_BAR; PG8_SCHED;
            PG8_LDB(B0, 1, 0); PG8_LDB(B1, 1, 1); PG8_SCHED; PG8_LDA(At, 1, 0); PG8_STAGE(PG8_SA(0, 1), a2, v2[1]);
            PG8_WAIT_V(8); PG8_WAIT_L(0); PG8_BAR; PG8_MMA(0, 0, At, B0); PG8_MMA(0, 1, At, B1); PG8_BAR; PG8_SCHED;
            PG8_LDA(At, 1, 1); PG8_STAGE(PG8_SB(1, 0), b3, voffB); PG8_STAGE(PG8_SB(1, 1), b3 + hstep, voffB); PG8_STAGE(PG8_SA(1, 0), a3, v2[0]);
            PG8_WAIT_V(8); PG8_WAIT_L(0); PG8_BAR; PG8_MMA(1, 0, At, B0); PG8_MMA(1, 1, At, B1); PG8_BAR; PG8_SCHED;
        }
        if (wr == 0) PG8_BAR;
        if constexpr (F8) {
            asm volatile("s_nop 15\n\ts_nop 15" : "+v"(acc[0][0][0][0]), "+v"(acc[0][0][0][1]), "+v"(acc[0][0][1][0]), "+v"(acc[0][0][1][1]), "+v"(acc[0][0][2][0]), "+v"(acc[0][0][2][1]), "+v"(acc[0][0][3][0]), "+v"(acc[0][0][3][1]),
                         "+v"(acc[0][1][0][0]), "+v"(acc[0][1][0][1]), "+v"(acc[0][1][1][0]), "+v"(acc[0][1][1][1]), "+v"(acc[0][1][2][0]), "+v"(acc[0][1][2][1]), "+v"(acc[0][1][3][0]), "+v"(acc[0][1][3][1]));
            asm volatile("s_nop 0" : "+v"(acc[1][0][0][0]), "+v"(acc[1][0][0][1]), "+v"(acc[1][0][1][0]), "+v"(acc[1][0][1][1]), "+v"(acc[1][0][2][0]), "+v"(acc[1][0][2][1]), "+v"(acc[1][0][3][0]), "+v"(acc[1][0][3][1]),
                         "+v"(acc[1][1][0][0]), "+v"(acc[1][1][0][1]), "+v"(acc[1][1][1][0]), "+v"(acc[1][1][1][1]), "+v"(acc[1][1][2][0]), "+v"(acc[1][1][2][1]), "+v"(acc[1][1][3][0]), "+v"(acc[1][1][3][1]));
        }
        E(acc, cur, wr, wc, fr, fq);
        if (!has_next) break;
#pragma unroll
        for (int a = 0; a < 2; ++a)
#pragma unroll
            for (int b = 0; b < 2; ++b)
#pragma unroll
                for (int m = 0; m < 4; ++m)
#pragma unroll
                    for (int n = 0; n < 2; ++n) acc[a][b][m][n] = (f32x4){0.f, 0.f, 0.f, 0.f};
        cur = nxt; cB = nB; ++ui;
#pragma unroll
        for (int h = 0; h < 2; ++h)
#pragma unroll
            for (int i = 0; i < 2; ++i) vA[h][i] = vN[h][i];
        if (wr == 1) PG8_BAR;
    }
    PG8_WAIT_V(0);
    PG8_BAR;
#undef PG8_SA
#undef PG8_SB
#undef PG8_STAGE
#undef PG8_LDA
#undef PG8_LDB
#undef PG8_MMA
#undef PG8_WAIT_V
#undef PG8_WAIT_L
#undef PG8_BAR
#undef PG8_SCHED
#undef PG8_AOFFS
}

__device__ __forceinline__ u32x4 pack8(const f32x4& v0, const f32x4& v1) { u32x4 w; w.x = cvtpk(v0[0], v0[1]); w.y = cvtpk(v0[2], v0[3]); w.z = cvtpk(v1[0], v1[1]); w.w = cvtpk(v1[2], v1[3]); return w; }

struct EpiQKV {
    bf16_t* PB; bf16_t* QKV; const float* rope;
    __device__ __forceinline__ void operator()(const f32x4 (&acc)[2][2][4][2], const Unit& u, int wr, int wc, int fr, int fq) const {
        const int ct = u.pc * 256, region = ct / 512;
        const bool ropew = (region == 3 || region == 4) && ((wc & 1) == 0);
        const float qs = (region == 3) ? QSCALE : 1.0f;
        const float sgn = (fq == 0) ? -1.0f : 1.0f;
#pragma unroll
        for (int ai = 0; ai < 2; ++ai) {
            f32x4 cs[4][4];
            if (ropew) {
#pragma unroll
                for (int m = 0; m < 4; ++m) { const int r = u.pm * 256 + ai * 128 + wr * 64 + m * 16 + fr;
#pragma unroll
                    for (int i = 0; i < 4; ++i) cs[m][i] = *(const f32x4*)(rope + (size_t)r * 16 + 4 * i); }
            }
            __builtin_amdgcn_sched_barrier(0);
#pragma unroll
            for (int m = 0; m < 4; ++m) {
                const int r = u.pm * 256 + ai * 128 + wr * 64 + m * 16 + fr;
#pragma unroll
                for (int bj = 0; bj < 2; ++bj) {
                    f32x4 v0 = acc[ai][bj][m][0], v1 = acc[ai][bj][m][1];
                    if (ropew) {
                        f32x4 p0, p1;
#pragma unroll
                        for (int j = 0; j < 4; ++j) { p0[j] = __shfl_xor(v0[j], 16); p1[j] = __shfl_xor(v1[j], 16); }
                        if (fq < 2) {
                            v0[0] = v0[0] * cs[m][0][0] + sgn * p0[0] * cs[m][0][1]; v0[1] = v0[1] * cs[m][0][2] + sgn * p0[1] * cs[m][0][3];
                            v0[2] = v0[2] * cs[m][1][0] + sgn * p0[2] * cs[m][1][1]; v0[3] = v0[3] * cs[m][1][2] + sgn * p0[3] * cs[m][1][3];
                            v1[0] = v1[0] * cs[m][2][0] + sgn * p1[0] * cs[m][2][1]; v1[1] = v1[1] * cs[m][2][2] + sgn * p1[1] * cs[m][2][3];
                            v1[2] = v1[2] * cs[m][3][0] + sgn * p1[2] * cs[m][3][1]; v1[3] = v1[3] * cs[m][3][2] + sgn * p1[3] * cs[m][3][3];
                        }
                    }
                    v0 = v0 * qs; v1 = v1 * qs;
                    if (u.pc < 2) *(u32x4*)(PB + (size_t)r * PBW + ct + bj * 128 + wc * 32 + 8 * fq) = pack8(v0, v1);
                    else if (u.pc < 6) { if (bj == 0) *(u32x4*)(PB + (size_t)r * PBW + 512 + (u.pc - 2) * 128 + wc * 32 + 8 * fq) = pack8(acc[ai][0][m][0] * acc[ai][1][m][0], acc[ai][0][m][1] * acc[ai][1][m][1]); }
                    else { const int hd = ((ct - region * 512) >> 6) + 2 * bj + (wc >> 1), d = 32 * (wc & 1) + 8 * fq, bb = r >> 11, ss = r & (SEQ - 1);
                        *(u32x4*)(QKV + (size_t)(region - 3) * ((size_t)M * 512) + ((size_t)(bb * NH + hd) * SEQ + ss) * 64 + d) = pack8(v0, v1); }
                }
            }
            __builtin_amdgcn_sched_barrier(0);
        }
    }
};
struct EpiRes {
    const bf16_t* XNb; const float* irstd; bf16_t* X1; bf16_t* XN2;
    __device__ __forceinline__ void operator()(const f32x4 (&acc)[2][2][4][2], const Unit& u, int wr, int wc, int fr, int fq) const {
        const size_t base = (size_t)(u.pm * 256 + wr * 64 + fr) * DM + u.pc * 256 + wc * 32 + 8 * fq;
        float ir[2][4];
#pragma unroll
        for (int ai = 0; ai < 2; ++ai)
#pragma unroll
            for (int m = 0; m < 4; ++m) ir[ai][m] = irstd[u.pm * 256 + ai * 128 + wr * 64 + m * 16 + fr];
        u32x4 xa[2][2], xb[2][2];
#define ER_OFF(b, mm, bj) (base + (size_t)(((b) >> 1) * 128 + (2 * ((b) & 1) + (mm)) * 16) * DM + (bj) * 128)
#define ER_LOAD(X, b) do { _Pragma("unroll") for (int mm = 0; mm < 2; ++mm) _Pragma("unroll") for (int bj = 0; bj < 2; ++bj) X[mm][bj] = *(const u32x4*)(XNb + ER_OFF(b, mm, bj)); } while (0)
#define ER_PROC(X, b) do { _Pragma("unroll") for (int mm = 0; mm < 2; ++mm) _Pragma("unroll") for (int bj = 0; bj < 2; ++bj) { const size_t off = ER_OFF(b, mm, bj); \
            const float iq = ir[(b) >> 1][2 * ((b) & 1) + mm]; const u32x4 xw = X[mm][bj]; \
            const f32x4 v0 = acc[(b) >> 1][bj][2 * ((b) & 1) + mm][0] + (f32x4){bf_lo(xw.x), bf_hi(xw.x), bf_lo(xw.y), bf_hi(xw.y)} * iq, v1 = acc[(b) >> 1][bj][2 * ((b) & 1) + mm][1] + (f32x4){bf_lo(xw.z), bf_hi(xw.z), bf_lo(xw.w), bf_hi(xw.w)} * iq; \
            *(u32x4*)(X1 + off) = pack8(v0, v1); \
            if (EXP_FP8) { u32x2 w; w.x = cvt4_fp8(v0[0], v0[1], v0[2], v0[3]); w.y = cvt4_fp8(v1[0], v1[1], v1[2], v1[3]); *(u32x2*)((unsigned char*)XN2 + off) = w; } \
            else *(u32x4*)(XN2 + off) = pack8(v0, v1); } } while (0)
        {
            u32x4 xc[2][2], xd[2][2];
            ER_LOAD(xa, 0); ER_LOAD(xb, 1); ER_LOAD(xc, 2); ER_LOAD(xd, 3); __builtin_amdgcn_sched_barrier(0);
            ER_PROC(xa, 0); ER_PROC(xb, 1); ER_PROC(xc, 2); ER_PROC(xd, 3);
        }
#undef ER_OFF
#undef ER_LOAD
#undef ER_PROC
    }
};
struct EpiSwiGLU {
    bf16_t* H; const float* rsg;
    __device__ __forceinline__ void operator()(const f32x4 (&acc)[2][2][4][2], const Unit& u, int wr, int wc, int fr, int fq) const {
        float rsv[2][4];
#pragma unroll
        for (int ai = 0; ai < 2; ++ai)
#pragma unroll
            for (int m = 0; m < 4; ++m) rsv[ai][m] = rsg[u.pm * 256 + ai * 128 + wr * 64 + m * 16 + fr];
        __builtin_amdgcn_sched_barrier(0);
#pragma unroll
        for (int ai = 0; ai < 2; ++ai)
#pragma unroll
            for (int m = 0; m < 4; ++m) {
                const int r = u.pm * 256 + ai * 128 + wr * 64 + m * 16 + fr;
                const float rs = rsv[ai][m];
                f32x4 h[2];
                if (SWIGLU_LEAN) {
                    const float crs = -1.4426950408889634f * rs, irs2 = __builtin_amdgcn_rcpf(rs * rs);
#pragma unroll
                    for (int n = 0; n < 2; ++n) {
                        const f32x4 g = acc[ai][0][m][n], gu = g * acc[ai][1][m][n];
#pragma unroll
                        for (int j = 0; j < 4; ++j) h[n][j] = gu[j] * __builtin_amdgcn_rcpf(__builtin_fmaf(__builtin_amdgcn_exp2f(g[j] * crs), irs2, irs2));
                    }
                } else
#pragma unroll
                for (int n = 0; n < 2; ++n)
#pragma unroll
                    for (int j = 0; j < 4; ++j) {
                        const float gv = acc[ai][0][m][n][j] * rs, uv = acc[ai][1][m][n][j] * rs;
                        const float sg = __builtin_amdgcn_rcpf(1.0f + __builtin_amdgcn_exp2f(-1.4426950408889634f * gv));
                        h[n][j] = gv * sg * uv;
                    }
                if (EXP_FP8) { u32x2 w; w.x = cvt4_fp8(h[0][0], h[0][1], h[0][2], h[0][3]); w.y = cvt4_fp8(h[1][0], h[1][1], h[1][2], h[1][3]); *(u32x2*)((unsigned char*)H + (size_t)r * DFF + u.pc * 128 + wc * 32 + 8 * fq) = w; }
                else *(u32x4*)(H + (size_t)r * DFF + u.pc * 128 + wc * 32 + 8 * fq) = pack8(h[0], h[1]);
            }
    }
};
struct EpiContrib {
    bf16_t* CN; const float* gatev;
    __device__ __forceinline__ void operator()(const f32x4 (&acc)[2][2][4][2], const Unit& u, int wr, int wc, int fr, int fq) const {
        float gv[2][4];
#pragma unroll
        for (int ai = 0; ai < 2; ++ai)
#pragma unroll
            for (int m = 0; m < 4; ++m) gv[ai][m] = gatev[u.pm * 256 + ai * 128 + wr * 64 + m * 16 + fr] * (EXP_FP8 ? W8_INV * CN_SCALE : 1.0f);
        __builtin_amdgcn_sched_barrier(0);
#pragma unroll
        for (int ai = 0; ai < 2; ++ai)
#pragma unroll
            for (int m = 0; m < 4; ++m) {
                const int r = u.pm * 256 + ai * 128 + wr * 64 + m * 16 + fr;
                const float gt = gv[ai][m];
#pragma unroll
                for (int bj = 0; bj < 2; ++bj) {
                    const f32x4 c0 = acc[ai][bj][m][0] * gt, c1 = acc[ai][bj][m][1] * gt;
                    if (EXP_FP8) { u32x2 w; w.x = cvt4_fp8(c0[0], c0[1], c0[2], c0[3]); w.y = cvt4_fp8(c1[0], c1[1], c1[2], c1[3]); *(u32x2*)((unsigned char*)CN + (size_t)r * DM + u.pc * 256 + bj * 128 + wc * 32 + 8 * fq) = w; }
                    else *(u32x4*)(CN + (size_t)r * DM + u.pc * 256 + bj * 128 + wc * 32 + 8 * fq) = pack8(c0, c1); }
            }
    }
};

typedef short v4i16_t __attribute__((ext_vector_type(4)));
__device__ __forceinline__ u32x2 lds_tr16(LAS unsigned char* p) { return __builtin_bit_cast(u32x2, __builtin_amdgcn_ds_read_tr16_b64_v4i16((LAS v4i16_t*)p)); }
__device__ __forceinline__ void transpose_item(const float* W, int ldn, const float* kscale, bf16_t* WT, int ldk, int k0, int n0, size_t dst_row0, LAS unsigned char* scr, int lane) {
    const int lr = lane >> 4, lc = lane & 15;
    f32x4 v[16]; float sc[16];
    const float* src = W + (size_t)(k0 + lr) * ldn + n0 + 4 * lc;
#pragma unroll
    for (int i = 0; i < 16; ++i) v[i] = __builtin_nontemporal_load((const f32x4*)(src + (size_t)(4 * i) * ldn));
    if (kscale) {
#pragma unroll
        for (int i = 0; i < 16; ++i) sc[i] = kscale[k0 + 4 * i + lr];
    } else {
#pragma unroll
        for (int i = 0; i < 16; ++i) sc[i] = 1.0f;
    }
#pragma unroll
    for (int i = 0; i < 16; ++i) { u32x2 w; w.x = cvtpk(v[i].x * sc[i], v[i].y * sc[i]); w.y = cvtpk(v[i].z * sc[i], v[i].w * sc[i]); *(LAS u32x2*)(scr + (4 * i + lr) * 128 + 8 * lc) = w; }
    LDS_WAIT(); asm volatile("" ::: "memory");
    const int gi = lane >> 4, q = (lane & 15) >> 2, p = lane & 3;
#pragma unroll
    for (int nb = 0; nb < 4; ++nb)
#pragma unroll
        for (int kh = 0; kh < 2; ++kh) {
            const int kb = 8 * (4 * kh + gi);
            LAS unsigned char* a = scr + (kb + q) * 128 + (16 * nb + 4 * p) * 2;
            const u32x2 lo = lds_tr16(a), hi = lds_tr16(a + 512);
            u32x4 o; o.x = lo.x; o.y = lo.y; o.z = hi.x; o.w = hi.y;
            __builtin_nontemporal_store(o, (u32x4*)(WT + (dst_row0 + 16 * nb + (lane & 15)) * (size_t)ldk + k0 + kb));
        }
    LDS_WAIT(); asm volatile("" ::: "memory");
}
struct CvItem { const float* W; const float* ks; unsigned char* WT; int ldn, ldk, k0, n0; size_t row0; };
__device__ __forceinline__ void cv_load(const CvItem& c, f32x4 (&v)[16], float (&sc)[16], int lane) {
    const int lr = lane >> 4, lc = lane & 15;
    const float* src = c.W + (size_t)(c.k0 + lr) * c.ldn + c.n0 + 4 * lc;
#pragma unroll
    for (int i = 0; i < 16; ++i) v[i] = __builtin_nontemporal_load((const f32x4*)(src + (size_t)(4 * i) * c.ldn));
    if (c.ks) {
#pragma unroll
        for (int i = 0; i < 16; ++i) sc[i] = c.ks[c.k0 + 4 * i + lr];
    } else {
#pragma unroll
        for (int i = 0; i < 16; ++i) sc[i] = 1.0f;
    }
}
__device__ __forceinline__ void cv_finish_f8(const CvItem& c, const f32x4 (&v)[16], const float (&sc)[16], float mult, LAS unsigned char* scr, int lane) {
    const int lr = lane >> 4, lc = lane & 15;
#pragma unroll
    for (int i = 0; i < 16; ++i) { const float m = sc[i] * mult; u32x2 w; w.x = cvtpk(v[i].x * m, v[i].y * m); w.y = cvtpk(v[i].z * m, v[i].w * m); *(LAS u32x2*)(scr + (4 * i + lr) * 128 + 8 * lc) = w; }
    LDS_WAIT(); asm volatile("" ::: "memory");
    const int gi = lane >> 4, q = (lane & 15) >> 2, p = lane & 3;
#pragma unroll
    for (int nb = 0; nb < 4; ++nb) {
        LAS unsigned char* a = scr + (16 * gi + q) * 128 + (16 * nb + 4 * p) * 2;
        u32x4 o;
#pragma unroll
        for (int r = 0; r < 4; ++r) { const u32x2 t = lds_tr16(a + r * 512); o[r] = cvt4_fp8(bf_lo(t.x), bf_hi(t.x), bf_lo(t.y), bf_hi(t.y)); }
        __builtin_nontemporal_store(o, (u32x4*)(c.WT + (c.row0 + 16 * nb + (lane & 15)) * (size_t)c.ldk + c.k0 + 16 * gi));
    }
    LDS_WAIT(); asm volatile("" ::: "memory");
}
__device__ __forceinline__ void transpose_item_f8(const float* W, int ldn, const float* kscale, float mult, unsigned char* WT, int ldk, int k0, int n0, size_t dst_row0, LAS unsigned char* scr, int lane) {
    CvItem c{W, kscale, WT, ldn, ldk, k0, n0, dst_row0}; f32x4 v[16]; float sc[16];
    cv_load(c, v, sc, lane); cv_finish_f8(c, v, sc, mult, scr, lane);
}
constexpr int I_IN = 16 * 48, I_OUT = 16 * 16, I_G = 16 * 16 * 32, I_D = 16 * 32 * 16, NITEMS = I_IN + I_OUT + 2 * I_G + I_D;
__device__ __forceinline__ void convert_items(Frame& F, int first, int last, LAS unsigned char* scr, int r_lo = 0, int r_hi = 1 << 20, int gw_ = -1, int ngw_ = 0) {
    const int gw = gw_ >= 0 ? gw_ : F.vcu * NWAVES + F.wave, NGW = gw_ >= 0 ? ngw_ : F.G * NWAVES;
    bf16_t* Win_t = (bf16_t*)(F.ws + WS_WIN); bf16_t* Wout_t = (bf16_t*)(F.ws + WS_WOUT); bf16_t* Wgu_t = (bf16_t*)(F.ws + WS_WGU); bf16_t* Wd_t = (bf16_t*)(F.ws + WS_WD);
    int rd = r_lo, it = first + gw + r_lo * NGW;
    for (; rd < r_hi && it < last && it < I_IN + I_OUT; ++rd, it += NGW) {
        int r = it;
        if (r < I_IN) { const int kb = r / 48, nb = r % 48, n0 = 64 * nb;
            const int drow = (n0 < 512 || n0 >= 1536) ? n0 : (n0 < 1024 ? 512 + ((n0 - 512) / 128) * 256 + ((n0 - 512) % 128) : 512 + ((n0 - 1024) / 128) * 256 + 128 + ((n0 - 1024) % 128));
            transpose_item(F.w_in, PW, F.g_mix, Win_t, DM, 64 * kb, n0, drow, scr, F.lane); continue; } r -= I_IN;
        { const int kb = r / 16, nb = r % 16; const float* ks = (kb < 8) ? F.g_conv : (F.g_attn - 512); transpose_item(F.w_out, DM, ks, Wout_t, DM, 64 * kb, 64 * nb, 64 * nb, scr, F.lane); }
    }
    if (EXP_FP8) {
#define CV_MAKE(c, item) do { int r_ = (item) - I_IN - I_OUT; if (r_ < 2 * I_G) { const int which = r_ / I_G; r_ %= I_G; const int e = r_ / 512, q = r_ % 512, kb = q / 32, nb = q % 32, n0 = 64 * nb; \
            c.W = (which ? F.w_up : F.w_gate) + (size_t)e * DM * DFF; c.ks = F.g_ffn; c.WT = (unsigned char*)Wgu_t + (size_t)e * 4096 * DM; c.ldn = DFF; c.ldk = DM; c.k0 = 64 * kb; c.n0 = n0; c.row0 = (size_t)(n0 / 128) * 256 + which * 128 + (n0 % 128); } \
          else { r_ -= 2 * I_G; const int e = r_ / 512, q = r_ % 512, kb = q / 16, nb = q % 16; \
            c.W = F.w_down + (size_t)e * DFF * DM; c.ks = nullptr; c.WT = (unsigned char*)Wd_t + (size_t)e * DM * DFF; c.ldn = DM; c.ldk = DFF; c.k0 = 64 * kb; c.n0 = 64 * nb; c.row0 = (size_t)(64 * nb); } } while (0)
        if (rd < r_hi && it < last) {
            f32x4 va[16], vb[16]; float sa[16], sb[16];
            { CvItem c; CV_MAKE(c, it); cv_load(c, va, sa, F.lane); }
            for (;;) {
                bool more = (rd + 1 < r_hi) && (it + NGW < last);
                if (more) { CvItem c; CV_MAKE(c, it + NGW); cv_load(c, vb, sb, F.lane); }
                __builtin_amdgcn_sched_barrier(0);
                { CvItem c; CV_MAKE(c, it); cv_finish_f8(c, va, sa, W8_SCALE, scr, F.lane); }
                if (!more) break;
                ++rd; it += NGW;
                more = (rd + 1 < r_hi) && (it + NGW < last);
                if (more) { CvItem c; CV_MAKE(c, it + NGW); cv_load(c, va, sa, F.lane); }
                __builtin_amdgcn_sched_barrier(0);
                { CvItem c; CV_MAKE(c, it); cv_finish_f8(c, vb, sb, W8_SCALE, scr, F.lane); }
                if (!more) break;
                ++rd; it += NGW;
            }
        }
#undef CV_MAKE
        return;
    }
    for (; rd < r_hi && it < last; ++rd, it += NGW) {
        int r = it;
        if (r < I_IN) { const int kb = r / 48, nb = r % 48, n0 = 64 * nb;
            const int drow = (n0 < 512 || n0 >= 1536) ? n0 : (n0 < 1024 ? 512 + ((n0 - 512) / 128) * 256 + ((n0 - 512) % 128) : 512 + ((n0 - 1024) / 128) * 256 + 128 + ((n0 - 1024) % 128));
            transpose_item(F.w_in, PW, F.g_mix, Win_t, DM, 64 * kb, n0, drow, scr, F.lane); continue; } r -= I_IN;
        if (r < I_OUT) { const int kb = r / 16, nb = r % 16; const float* ks = (kb < 8) ? F.g_conv : (F.g_attn - 512); transpose_item(F.w_out, DM, ks, Wout_t, DM, 64 * kb, 64 * nb, 64 * nb, scr, F.lane); continue; } r -= I_OUT;
        if (r < 2 * I_G) { const int which = r / I_G; r %= I_G; const int e = r / 512, q = r % 512, kb = q / 32, nb = q % 32, n0 = 64 * nb;
            const float* W = (which ? F.w_up : F.w_gate) + (size_t)e * DM * DFF;
            if (EXP_FP8) transpose_item_f8(W, DFF, F.g_ffn, W8_SCALE, (unsigned char*)Wgu_t + (size_t)e * 4096 * DM, DM, 64 * kb, n0, (size_t)(n0 / 128) * 256 + which * 128 + (n0 % 128), scr, F.lane);
            else transpose_item(W, DFF, F.g_ffn, Wgu_t + (size_t)e * 4096 * DM, DM, 64 * kb, n0, (size_t)(n0 / 128) * 256 + which * 128 + (n0 % 128), scr, F.lane); continue; } r -= 2 * I_G;
        { const int e = r / 512, q = r % 512, kb = q / 16, nb = q % 16;
            if (EXP_FP8) transpose_item_f8(F.w_down + (size_t)e * DFF * DM, DM, nullptr, W8_SCALE, (unsigned char*)Wd_t + (size_t)e * DM * DFF, DFF, 64 * kb, 64 * nb, 64 * nb, scr, F.lane);
            else transpose_item(F.w_down + (size_t)e * DFF * DM, DM, nullptr, Wd_t + (size_t)e * DM * DFF, DFF, 64 * kb, 64 * nb, 64 * nb, scr, F.lane); }
    }
}
__device__ __forceinline__ void p0_prologue(Frame& F) {
    const int gw = F.vcu * NWAVES + F.wave, NGW = F.G * NWAVES;
    convert_items(F, 0, OVERLAP_CONV ? I_IN : NITEMS, F.lds + F.wave * 16384, 0, 1 << 20, F.wave * F.G + F.vcu, F.G * NWAVES);
    bf16_t* XN = (bf16_t*)(F.ws + WS_XN);
    for (int m0 = gw * 8; m0 < M; m0 += NGW * 8) {
        f32x4 v[8][4];
#pragma unroll
        for (int rr = 0; rr < 8; ++rr) { const f32x4* xr = (const f32x4*)(F.x + (size_t)(m0 + rr) * DM) + F.lane;
#pragma unroll
            for (int j = 0; j < 4; ++j) v[rr][j] = xr[64 * j]; }
        __builtin_amdgcn_sched_barrier(0);
#pragma unroll
        for (int rr = 0; rr < 8; ++rr) {
            float ss = 0.f;
#pragma unroll
            for (int j = 0; j < 4; ++j) ss += (v[rr][j].x * v[rr][j].x + v[rr][j].y * v[rr][j].y) + (v[rr][j].z * v[rr][j].z + v[rr][j].w * v[rr][j].w);
            const float rstd = 1.0f / sqrtf(wave_sum(ss) * (1.f / DM) + RMS_EPS);
            if (F.lane == 0) ((float*)(F.ws + WS_IRSTD1))[m0 + rr] = 1.0f / rstd;
            u32x2* o = (u32x2*)(XN + (size_t)(m0 + rr) * DM) + F.lane;
#pragma unroll
            for (int j = 0; j < 4; ++j) { u32x2 w; w.x = cvtpk(v[rr][j].x * rstd, v[rr][j].y * rstd); w.y = cvtpk(v[rr][j].z * rstd, v[rr][j].w * rstd); o[64 * j] = w; }
        }
    }
    float* rope = (float*)(F.ws + WS_ROPE);
    for (int i = (F.vcu * NTHREADS + F.tid); i < M * 8; i += F.G * NTHREADS) {
        const int tok = i >> 3, f = i & 7;
        const float invf = (f == 0) ? 1.0f : (f == 1) ? 0.19392274474868576f : (f == 2) ? 0.037606030930863933f : (f == 3) ? 0.0072926647372171093f : (f == 4) ? 0.001414213562373095f : (f == 5) ? 0.0002742481756762073f : (f == 6) ? 5.3182958969449883e-05f : 1.031338537721246e-05f;
        const float ang = (float)F.pos[tok] * invf;
        float sn, cs; sincosf(ang, &sn, &cs);
        rope[2 * i] = cs; rope[2 * i + 1] = sn;
    }
}

__device__ __forceinline__ int crow(int r, int hi) { return (r & 3) + 8 * (r >> 2) + 4 * hi; }
struct QBlk { bf16x8 qr[4]; f32x16 o0, o1; float m, l; };
__device__ __forceinline__ void att_block_step(QBlk& q, const bf16x8 (&kf)[4], const bf16x8 (&vA)[2], const bf16x8 (&vC)[2], bool masked, int lq, int lk0, int hi) {
    f32x16 p = {};
#pragma unroll
    for (int d0 = 0; d0 < 4; ++d0) p = __builtin_amdgcn_mfma_f32_32x32x16_bf16(kf[d0], q.qr[d0], p, 0, 0, 0);
    if (masked) {
#pragma unroll
        for (int r = 0; r < 16; ++r) { const int dd = lq - (lk0 + crow(r, hi)); if (dd > 64 || dd < -64) p[r] = -1e30f; } }
    float mx = p[0];
#pragma unroll
    for (int r = 1; r < 16; ++r) mx = fmaxf(mx, p[r]);
    mx = fmaxf(mx, __shfl_xor(mx, 32));
    const float mnew = fmaxf(q.m, mx);
    const float alpha = __builtin_amdgcn_exp2f(q.m - mnew);
    float rs = 0.f;
#pragma unroll
    for (int r = 0; r < 16; ++r) { p[r] = __builtin_amdgcn_exp2f(p[r] - mnew); rs += p[r]; }
    q.l = q.l * alpha + rs;
    if (__any(mnew > q.m)) {
#pragma unroll
        for (int r = 0; r < 16; ++r) { q.o0[r] *= alpha; q.o1[r] *= alpha; } }
    q.m = mnew;
#pragma unroll
    for (int s2 = 0; s2 < 2; ++s2) {
        u32x4 wv; wv.x = cvtpk(p[8 * s2 + 0], p[8 * s2 + 1]); wv.y = cvtpk(p[8 * s2 + 2], p[8 * s2 + 3]); wv.z = cvtpk(p[8 * s2 + 4], p[8 * s2 + 5]); wv.w = cvtpk(p[8 * s2 + 6], p[8 * s2 + 7]);
        const bf16x8 pf = __builtin_bit_cast(bf16x8, wv);
        q.o0 = __builtin_amdgcn_mfma_f32_32x32x16_bf16(vA[s2], pf, q.o0, 0, 0, 0);
        q.o1 = __builtin_amdgcn_mfma_f32_32x32x16_bf16(vC[s2], pf, q.o1, 0, 0, 0);
    }
}
__device__ __forceinline__ void att_block_store(const QBlk& q, bf16_t* op, float* mlp, int hi) {
    const float ltot = q.l + __shfl_xor(q.l, 32);
    const float il = 1.0f / ltot;
#pragma unroll
    for (int g4 = 0; g4 < 4; ++g4) {
        u32x2 w0, w1;
        w0.x = cvtpk(q.o0[4 * g4 + 0] * il, q.o0[4 * g4 + 1] * il); w0.y = cvtpk(q.o0[4 * g4 + 2] * il, q.o0[4 * g4 + 3] * il);
        w1.x = cvtpk(q.o1[4 * g4 + 0] * il, q.o1[4 * g4 + 1] * il); w1.y = cvtpk(q.o1[4 * g4 + 2] * il, q.o1[4 * g4 + 3] * il);
        *(u32x2*)(op + 8 * g4 + 4 * hi) = w0; *(u32x2*)(op + 32 + 8 * g4 + 4 * hi) = w1;
    }
    if (hi == 0) { f32x2 ml = {q.m, ltot}; *(f32x2*)mlp = ml; }
}
__device__ __forceinline__ void att_block_store_rows(const QBlk& q, LAS unsigned char* t, bf16_t* opb, int tok0, int tstride, float* mlb, int lane, int r32, int hi) {
    const float ltot = q.l + __shfl_xor(q.l, 32);
    const float il = 1.0f / ltot;
#pragma unroll
    for (int g4 = 0; g4 < 4; ++g4) {
        u32x2 w0, w1;
        w0.x = cvtpk(q.o0[4 * g4 + 0] * il, q.o0[4 * g4 + 1] * il); w0.y = cvtpk(q.o0[4 * g4 + 2] * il, q.o0[4 * g4 + 3] * il);
        w1.x = cvtpk(q.o1[4 * g4 + 0] * il, q.o1[4 * g4 + 1] * il); w1.y = cvtpk(q.o1[4 * g4 + 2] * il, q.o1[4 * g4 + 3] * il);
        *(LAS u32x2*)(t + r32 * 128 + ((g4 ^ (r32 & 7)) * 16) + 8 * hi) = w0;
        *(LAS u32x2*)(t + r32 * 128 + (((4 + g4) ^ (r32 & 7)) * 16) + 8 * hi) = w1;
    }
    LDS_WAIT(); asm volatile("" ::: "memory");
    const int rr = lane >> 3, ch = lane & 7;
    u32x4 v[4];
#pragma unroll
    for (int j = 0; j < 4; ++j) { const int row = 8 * j + rr; v[j] = *(const LAS u32x4*)(t + row * 128 + ((ch ^ (row & 7)) * 16)); }
#pragma unroll
    for (int j = 0; j < 4; ++j) { const int row = 8 * j + rr; *(u32x4*)(opb + (size_t)(tok0 + row * tstride) * 512 + 8 * ch) = v[j]; }
    if (hi == 0) { f32x2 ml = {q.m, ltot}; *(f32x2*)(mlb + (size_t)(tok0 + r32 * tstride) * 16) = ml; }
    LDS_WAIT(); asm volatile("" ::: "memory");
}
__device__ __forceinline__ void att_softmax_nb(QBlk& q, f32x16& p, bf16x8 (&pf)[2]) {
    float mx = p[0];
#pragma unroll
    for (int r = 1; r < 16; ++r) mx = fmaxf(mx, p[r]);
    mx = fmaxf(mx, __shfl_xor(mx, 32));
    const float mnew = fmaxf(q.m, mx);
    const float alpha = __builtin_amdgcn_exp2f(q.m - mnew);
    float rs = 0.f;
#pragma unroll
    for (int r = 0; r < 16; ++r) { p[r] = __builtin_amdgcn_exp2f(p[r] - mnew); rs += p[r]; }
    q.l = q.l * alpha + rs; q.m = mnew;
#pragma unroll
    for (int r = 0; r < 16; ++r) { q.o0[r] *= alpha; q.o1[r] *= alpha; }
#pragma unroll
    for (int s2 = 0; s2 < 2; ++s2) {
        u32x4 wv; wv.x = cvtpk(p[8 * s2 + 0], p[8 * s2 + 1]); wv.y = cvtpk(p[8 * s2 + 2], p[8 * s2 + 3]); wv.z = cvtpk(p[8 * s2 + 4], p[8 * s2 + 5]); wv.w = cvtpk(p[8 * s2 + 6], p[8 * s2 + 7]);
        pf[s2] = __builtin_bit_cast(bf16x8, wv); }
}
template <int DA, int DB>
__device__ __forceinline__ void att_pair_step(QBlk& a, QBlk& b, const bf16x8 (&kf)[4], const bf16x8 (&vA)[2], const bf16x8 (&vC)[2], const f32x16& bm, const f32x16& bp) {
    f32x16 pa = {}, pb = {};
    if constexpr (DA != 9) { pa = (DA == -2) ? bm : (DA == 2) ? bp : f32x16{};
#pragma unroll
        for (int d0 = 0; d0 < 4; ++d0) pa = __builtin_amdgcn_mfma_f32_32x32x16_bf16(kf[d0], a.qr[d0], pa, 0, 0, 0); }
    if constexpr (DB != 9) { pb = (DB == -2) ? bm : (DB == 2) ? bp : f32x16{};
#pragma unroll
        for (int d0 = 0; d0 < 4; ++d0) pb = __builtin_amdgcn_mfma_f32_32x32x16_bf16(kf[d0], b.qr[d0], pb, 0, 0, 0); }
    bf16x8 fa[2], fb[2];
    if constexpr (DA != 9) att_softmax_nb(a, pa, fa);
    if constexpr (DB != 9) att_softmax_nb(b, pb, fb);
    if constexpr (DA != 9) {
#pragma unroll
        for (int s2 = 0; s2 < 2; ++s2) { a.o0 = __builtin_amdgcn_mfma_f32_32x32x16_bf16(vA[s2], fa[s2], a.o0, 0, 0, 0); a.o1 = __builtin_amdgcn_mfma_f32_32x32x16_bf16(vC[s2], fa[s2], a.o1, 0, 0, 0); } }
    if constexpr (DB != 9) {
#pragma unroll
        for (int s2 = 0; s2 < 2; ++s2) { b.o0 = __builtin_amdgcn_mfma_f32_32x32x16_bf16(vA[s2], fb[s2], b.o0, 0, 0, 0); b.o1 = __builtin_amdgcn_mfma_f32_32x32x16_bf16(vC[s2], fb[s2], b.o1, 0, 0, 0); } }
}
template <int NWA> __device__ __forceinline__ void p2a_attention_w(Frame& F, int it_lo = 0, int it_hi = 1 << 30) {
    const bf16_t* QH = (const bf16_t*)(F.ws + WS_QH); const bf16_t* KH = (const bf16_t*)(F.ws + WS_KH); const bf16_t* VH = (const bf16_t*)(F.ws + WS_VH);
    bf16_t* OP = (bf16_t*)(F.ws + WS_OP); float* ML = (float*)(F.ws + WS_ML);
    const int NGW = F.G * NWA;
    constexpr int NTASK = BATCH * NH * 3 * 32;
    const int per = (NTASK + NGW - 1) / NGW;
    const int lane = F.lane, r32 = lane & 31, hi = lane >> 5;
    if (F.wave >= NWA) return;
    LAS unsigned char* kt_l = F.lds + F.wave * 16384;
    LAS unsigned char* vt_l = kt_l + 8192;
    const int vrow = lane >> 3, vch = lane & 7;
    const int ksrc = (vch ^ (vrow & 7)) * 8;
    LAS unsigned char* vtr = vt_l + (4 * hi + ((lane & 15) >> 2)) * 128 + (16 * ((lane >> 4) & 1) + 4 * (lane & 3)) * 2;
    LAS unsigned char* krd = kt_l + r32 * 128;
#define ATT_DMA(kt_, slot_) do { \
        _Pragma("unroll") for (int j = 0; j < 4; ++j) { const size_t ro = (size_t)((32 * (kt_) + vrow + 8 * j) * dl) * 64; \
            __builtin_amdgcn_global_load_lds((const unsigned*)(kbase + ro + ksrc), (LAS unsigned*)(kt_l + (slot_) * 4096 + j * 1024), 16, 0, 0); \
            __builtin_amdgcn_global_load_lds((const unsigned*)(vbase + ro + vch * 8), (LAS unsigned*)(vt_l + (slot_) * 4096 + j * 1024), 16, 0, 0); } } while (0)
    f32x16 bm, bp;
#pragma unroll
    for (int r = 0; r < 16; ++r) { bm[r] = (crow(r, hi) >= r32) ? 0.f : -1e30f; bp[r] = (crow(r, hi) <= r32) ? 0.f : -1e30f; }
    for (int it = it_lo; it < per && it < it_hi; ++it) {
        const int cpx = (F.G >= 8) ? (F.G >> 3) : 1, xg = F.vcu / cpx, jc = F.vcu % cpx;
        const int T = xg * (per * NWA * cpx) + it * (NWA * cpx) + jc * NWA + F.wave;
        if (T >= NTASK) continue;
        const int bh = T / 96, w = T % 96, pi = w / 32, a2 = w % 32;
        const int dl = (pi == 0) ? 1 : (pi == 1 ? 4 : 16);
        const int L = SEQ / dl, tpc = L / 32, hpc = tpc >> 1, rc = a2 / hpc, ta = 2 * (a2 % hpc);
        const size_t hb = (size_t)bh * SEQ;
        const bf16_t* kbase = KH + (hb + rc) * 64;
        const bf16_t* vbase = VH + (hb + rc) * 64;
        const int klo = (ta - 2 < 0) ? 0 : ta - 2, khi = (ta + 3 > tpc - 1) ? tpc - 1 : ta + 3, nt = khi - klo + 1;
        QBlk qa, qb;
        const int qposa = (32 * ta + r32) * dl + rc, qposb = qposa + 32 * dl;
#pragma unroll
        for (int d0 = 0; d0 < 4; ++d0) { qa.qr[d0] = *(const bf16x8*)(QH + (hb + qposa) * 64 + hi * 8 + d0 * 16); qb.qr[d0] = *(const bf16x8*)(QH + (hb + qposb) * 64 + hi * 8 + d0 * 16); }
        ATT_DMA(klo, 0);
        if (nt > 1) ATT_DMA(klo + 1, 1);
        qa.m = -1e30f; qa.l = 0.f; qa.o0 = f32x16{}; qa.o1 = f32x16{}; qb.m = -1e30f; qb.l = 0.f; qb.o0 = f32x16{}; qb.o1 = f32x16{};
#define ATT_TILE2(i_, DA_, DB_) do { const int kt = ta - 2 + (i_); if (kt >= 0 && kt < tpc) { \
            if ((i_) < 5 && kt + 1 < tpc) asm volatile("s_waitcnt vmcnt(8)" ::: "memory"); else asm volatile("s_waitcnt vmcnt(0)" ::: "memory"); \
            bf16x8 kf[4], vA[2], vC[2]; \
            _Pragma("unroll") for (int d0 = 0; d0 < 4; ++d0) kf[d0] = *(const LAS bf16x8*)(krd + ((i_) & 1) * 4096 + ((2 * d0 + hi) ^ (r32 & 7)) * 16); \
            LAS unsigned char* vs = vtr + ((i_) & 1) * 4096; \
            _Pragma("unroll") for (int s2 = 0; s2 < 2; ++s2) { \
                const u32x2 a0 = lds_tr16(vs + s2 * 2048), a1 = lds_tr16(vs + s2 * 2048 + 1024); \
                const u32x2 c0 = lds_tr16(vs + s2 * 2048 + 64), c1 = lds_tr16(vs + s2 * 2048 + 1024 + 64); \
                u32x4 va, vc; va.x = a0.x; va.y = a0.y; va.z = a1.x; va.w = a1.y; vc.x = c0.x; vc.y = c0.y; vc.z = c1.x; vc.w = c1.y; \
                vA[s2] = __builtin_bit_cast(bf16x8, va); vC[s2] = __builtin_bit_cast(bf16x8, vc); } \
            LDS_WAIT(); __builtin_amdgcn_sched_barrier(0); \
            if ((i_) + 2 <= 5 && kt + 2 < tpc) ATT_DMA(kt + 2, (i_) & 1); \
            __builtin_amdgcn_sched_barrier(0); \
            att_pair_step<DA_, DB_>(qa, qb, kf, vA, vC, bm, bp); \
        } } while (0)
        ATT_TILE2(0, -2, 9); ATT_TILE2(1, -1, -2); ATT_TILE2(2, 0, -1); ATT_TILE2(3, 1, 0); ATT_TILE2(4, 2, 1); ATT_TILE2(5, 9, 2);
#undef ATT_TILE2
        if (ATT_ROWSTORE) {
            const int tka = (bh >> 3) * SEQ + (32 * ta) * dl + rc, tkb = tka + 32 * dl;
            bf16_t* opb = OP + (size_t)pi * M * 512 + (bh & 7) * 64; float* mlb = ML + ((size_t)pi * M * 8 + (bh & 7)) * 2;
            att_block_store_rows(qa, kt_l, opb, tka, dl, mlb, lane, r32, hi);
            att_block_store_rows(qb, kt_l + 4096, opb, tkb, dl, mlb, lane, r32, hi);
        } else {
        const size_t toka = (size_t)(bh >> 3) * SEQ + qposa, tokb = (size_t)(bh >> 3) * SEQ + qposb;
        att_block_store(qa, OP + ((size_t)pi * M + toka) * 512 + (bh & 7) * 64, ML + (((size_t)pi * M + toka) * 8 + (bh & 7)) * 2, hi);
        att_block_store(qb, OP + ((size_t)pi * M + tokb) * 512 + (bh & 7) * 64, ML + (((size_t)pi * M + tokb) * 8 + (bh & 7)) * 2, hi); }
    }
#undef ATT_DMA
}
__device__ __forceinline__ void p2a_attention(Frame& F, int it_lo = 0, int it_hi = 1 << 30) { p2a_attention_w<NWAVES>(F, it_lo, it_hi); }

__device__ __forceinline__ void unpack8(const u32x4 w, float (&o)[8]) { o[0] = bf_lo(w.x); o[1] = bf_hi(w.x); o[2] = bf_lo(w.y); o[3] = bf_hi(w.y); o[4] = bf_lo(w.z); o[5] = bf_hi(w.z); o[6] = bf_lo(w.w); o[7] = bf_hi(w.w); }
__device__ __forceinline__ void p2b_combine(Frame& F) {
    const bf16_t* PB = (const bf16_t*)(F.ws + WS_PB);
    const bf16_t* OP = (const bf16_t*)(F.ws + WS_OP); const float* ML = (const float*)(F.ws + WS_ML);
    bf16_t* Y = (bf16_t*)(F.ws + WS_Y);
    const int gw = F.vcu * NWAVES + F.wave, NGW = F.G * NWAVES, lane = F.lane, hh = lane >> 3;
    float cw[3][8];
#pragma unroll
    for (int t = 0; t < 3; ++t)
#pragma unroll
        for (int j = 0; j < 8; ++j) cw[t][j] = F.conv_w[t * 512 + 8 * lane + j];
    const int per = (M / 4 + NGW - 1) / NGW;
    for (int qd = gw * per; qd < (gw + 1) * per && qd < M / 4; ++qd) {
        const int tok0 = 4 * qd, s0 = tok0 & (SEQ - 1);
        u32x4 cu[6], cb[4], ow[4][3]; f32x2 ml[4][3];
#pragma unroll
        for (int t = 0; t < 6; ++t) { int ss = s0 + t - 1; ss = ss < 0 ? 0 : (ss > SEQ - 1 ? SEQ - 1 : ss); cu[t] = *(const u32x4*)(PB + (size_t)(tok0 - s0 + ss) * PBW + 512 + 8 * lane); }
#pragma unroll
        for (int k = 0; k < 4; ++k) { cb[k] = *(const u32x4*)(PB + (size_t)(tok0 + k) * PBW + 8 * lane);
#pragma unroll
            for (int p = 0; p < 3; ++p) { ml[k][p] = *(const f32x2*)(ML + (((size_t)p * M + tok0 + k) * 8 + hh) * 2); ow[k][p] = *(const u32x4*)(OP + ((size_t)p * M + tok0 + k) * 512 + 8 * lane); } }
        __builtin_amdgcn_sched_barrier(0);
        float uu[6][8];
#pragma unroll
        for (int t = 0; t < 6; ++t) { float b[8]; unpack8(cu[t], b); const int ss = s0 + t - 1; const float z = (ss >= 0 && ss < SEQ) ? 1.0f : 0.0f;
#pragma unroll
            for (int j = 0; j < 8; ++j) uu[t][j] = b[j] * z; }
#pragma unroll
        for (int k = 0; k < 4; ++k) {
            const float mm = fmaxf(fmaxf(ml[k][0].x, ml[k][1].x), ml[k][2].x);
            float wp[3], den = 0.f;
#pragma unroll
            for (int p = 0; p < 3; ++p) { wp[p] = __builtin_amdgcn_exp2f(ml[k][p].x - mm) * ml[k][p].y; den += wp[p]; }
            const float iden = 1.0f / den;
            float ya[8];
#pragma unroll
            for (int j = 0; j < 8; ++j) ya[j] = 0.f;
#pragma unroll
            for (int p = 0; p < 3; ++p) { float o[8]; unpack8(ow[k][p], o); const float c = wp[p] * iden;
#pragma unroll
                for (int j = 0; j < 8; ++j) ya[j] += c * o[j]; }
            float ssa = 0.f;
#pragma unroll
            for (int j = 0; j < 8; ++j) ssa += ya[j] * ya[j];
            float cbv[8]; unpack8(cb[k], cbv);
            float yc[8]; float ssc = 0.f;
#pragma unroll
            for (int j = 0; j < 8; ++j) { yc[j] = cbv[j] * (cw[0][j] * uu[k][j] + cw[1][j] * uu[k + 1][j] + cw[2][j] * uu[k + 2][j]); ssc += yc[j] * yc[j]; }
            const float ra = 1.0f / sqrtf(wave_sum(ssa) * (1.f / 512) + RMS_EPS), rc = 1.0f / sqrtf(wave_sum(ssc) * (1.f / 512) + RMS_EPS);
            u32x4 wa, wc4;
            wa.x = cvtpk(ya[0] * ra, ya[1] * ra); wa.y = cvtpk(ya[2] * ra, ya[3] * ra); wa.z = cvtpk(ya[4] * ra, ya[5] * ra); wa.w = cvtpk(ya[6] * ra, ya[7] * ra);
            wc4.x = cvtpk(yc[0] * rc, yc[1] * rc); wc4.y = cvtpk(yc[2] * rc, yc[3] * rc); wc4.z = cvtpk(yc[4] * rc, yc[5] * rc); wc4.w = cvtpk(yc[6] * rc, yc[7] * rc);
            *(u32x4*)(Y + (size_t)(tok0 + k) * DM + 8 * lane) = wc4;
            *(u32x4*)(Y + (size_t)(tok0 + k) * DM + 512 + 8 * lane) = wa;
        }
    }
}

__device__ __forceinline__ void p3b_router(Frame& F) {
    LAS float* gwP = (LAS float*)F.lds;
    for (int i = F.tid; i < DM * NE; i += NTHREADS) { const int k = i >> 4, e = i & 15; gwP[(((k >> 4) * 4 + ((k >> 2) & 3)) * 16 + e) * 4 + (k & 3)] = F.g_ffn[k] * F.w_router[i]; }
    __syncthreads();
    if (OVERLAP_CONV && F.G == 256 && F.wave >= 4)
        convert_items(F, NITEMS - N5_ITEMS - N6_ITEMS, NITEMS - N6_ITEMS, F.lds + F.wave * 16384, 0, 1 << 20, F.vcu * 4 + (F.wave - 4), F.G * 4);
    float* rstd2 = (float*)(F.ws + WS_RSTD2); float* aff = (float*)(F.ws + WS_AFF); int* inv = (int*)(F.ws + WS_INV);
    const int lane = F.lane, tk = lane & 15, q = lane >> 4;
    for (int grp = F.wave * F.G + F.vcu; grp < M / 16; grp += F.G * NWAVES) {
        const int t0 = grp * 16;
        const bf16_t* xrow = (const bf16_t*)(F.ws + WS_X1) + (size_t)(t0 + tk) * DM + 4 * q;
        f32x4 acc = {0.f, 0.f, 0.f, 0.f}; float ss = 0.f;
#pragma unroll 1
        for (int hf = 0; hf < 2; ++hf) {
            u32x2 vv[32];
#pragma unroll
            for (int c = 0; c < 32; ++c) vv[c] = *(const u32x2*)(xrow + 16 * (32 * hf + c));
            __builtin_amdgcn_sched_barrier(0);
#pragma unroll
            for (int c = 0; c < 32; ++c) {
                const f32x4 v = {bf_lo(vv[c].x), bf_hi(vv[c].x), bf_lo(vv[c].y), bf_hi(vv[c].y)};
                const f32x4 w = *(const LAS f32x4*)(gwP + (((32 * hf + c) * 4 + q) * 16 + tk) * 4);
                ss += (v.x * v.x + v.y * v.y) + (v.z * v.z + v.w * v.w);
                acc = __builtin_amdgcn_mfma_f32_16x16x4f32(v.x, w.x, acc, 0, 0, 0);
                acc = __builtin_amdgcn_mfma_f32_16x16x4f32(v.y, w.y, acc, 0, 0, 0);
                acc = __builtin_amdgcn_mfma_f32_16x16x4f32(v.z, w.z, acc, 0, 0, 0);
                acc = __builtin_amdgcn_mfma_f32_16x16x4f32(v.w, w.w, acc, 0, 0, 0);
            }
        }
        ss += __shfl_xor(ss, 16); ss += __shfl_xor(ss, 32);
        const float rstd = 1.0f / sqrtf(ss * (1.f / DM) + RMS_EPS);
        f32x4 lg;
#pragma unroll
        for (int r = 0; r < 4; ++r) lg[r] = acc[r] * __shfl(rstd, 4 * q + r);
        f32x4 mx = lg;
#pragma unroll
        for (int o = 1; o < 16; o <<= 1)
#pragma unroll
            for (int r = 0; r < 4; ++r) mx[r] = fmaxf(mx[r], __shfl_xor(mx[r], o));
        f32x4 ex, sm;
#pragma unroll
        for (int r = 0; r < 4; ++r) { ex[r] = expf(lg[r] - mx[r]); sm[r] = ex[r]; }
#pragma unroll
        for (int o = 1; o < 16; o <<= 1)
#pragma unroll
            for (int r = 0; r < 4; ++r) sm[r] += __shfl_xor(sm[r], o);
        f32x4 af;
#pragma unroll
        for (int r = 0; r < 4; ++r) af[r] = ex[r] / sm[r];
        const int b = t0 / SEQ, s0 = (t0 % SEQ) + 4 * q;
        *(f32x4*)(aff + ((size_t)b * NE + tk) * SEQ + s0) = af;
        *(int4*)(inv + (size_t)t0 * 16 + 4 * lane) = make_int4(-1, -1, -1, -1);
        if (q == 0) rstd2[t0 + tk] = rstd;
    }
    __syncthreads();
}

__device__ __forceinline__ void p4_topk(Frame& F) {
    const float* aff = (const float*)(F.ws + WS_AFF); int* arows = (int*)(F.ws + WS_AROWS); float* gatev = (float*)(F.ws + WS_GATEV); int* inv = (int*)(F.ws + WS_INV);
    float* rsg = (float*)(F.ws + WS_RSG); const float* rstd2 = (const float*)(F.ws + WS_RSTD2);
    volatile LAS int* cl = (volatile LAS int*)F.lds;
    const int lane = F.lane, w = F.wave;
    for (int task = F.vcu; task < BATCH * NE; task += F.G) {
        const int b = task / NE, e = task % NE, pm = e * 8 + b;
        unsigned v[4];
#pragma unroll
        for (int i = 0; i < 4; ++i) v[i] = __builtin_bit_cast(unsigned, aff[(size_t)task * SEQ + w * 256 + i * 64 + lane]);
        unsigned T = 0u;
        for (int bit = 30, rnd = 0; bit >= 0; bit -= 2, ++rnd) {
            const bool two = bit >= 1;
            const int lowb = two ? bit - 1 : bit;
            const unsigned c1 = T | (1u << lowb), c2 = T | (two ? (2u << lowb) : (1u << lowb)), c3 = T | (two ? (3u << lowb) : (1u << lowb));
            int n1 = 0, n2 = 0, n3 = 0;
#pragma unroll
            for (int i = 0; i < 4; ++i) { n1 += __builtin_popcountll(__ballot(v[i] >= c1)); n2 += __builtin_popcountll(__ballot(v[i] >= c2)); n3 += __builtin_popcountll(__ballot(v[i] >= c3)); }
            const int pb = (rnd & 1) * 32;
            if (lane == 0) { cl[pb + w] = n1; cl[pb + 8 + w] = n2; cl[pb + 16 + w] = n3; }
            __syncthreads();
            int t1 = 0, t2 = 0, t3 = 0;
#pragma unroll
            for (int j = 0; j < 8; ++j) { t1 += cl[pb + j]; t2 += cl[pb + 8 + j]; t3 += cl[pb + 16 + j]; }
            if (two) T = (t3 >= CAP) ? c3 : (t2 >= CAP) ? c2 : (t1 >= CAP) ? c1 : T;
            else T = (t1 >= CAP) ? c1 : T;
        }
        int gtc = 0, eqc = 0;
#pragma unroll
        for (int i = 0; i < 4; ++i) { gtc += __builtin_popcountll(__ballot(v[i] > T)); eqc += __builtin_popcountll(__ballot(v[i] == T)); }
        if (lane == 0) { cl[64 + w] = gtc; cl[72 + w] = eqc; }
        __syncthreads();
        int cgt = 0;
#pragma unroll
        for (int j = 0; j < 8; ++j) cgt += cl[64 + j];
        const int need = CAP - cgt;
        int base = 0, eqbase = 0;
        for (int j = 0; j < w; ++j) { const int g_ = cl[64 + j], q_ = cl[72 + j]; int take = need - eqbase; take = take < 0 ? 0 : (take > q_ ? q_ : take); base += g_ + take; eqbase += q_; }
        const unsigned long long lt = (1ull << lane) - 1ull;
#pragma unroll
        for (int i = 0; i < 4; ++i) {
            const bool eq = (v[i] == T);
            const unsigned long long meq = __ballot(eq);
            const int req = eqbase + __builtin_popcountll(meq & lt);
            const bool sel = (v[i] > T) || (eq && req < need);
            const unsigned long long ms = __ballot(sel);
            const int slot = base + __builtin_popcountll(ms & lt);
            if (sel) {
                const int sidx = w * 256 + i * 64 + lane;
                arows[pm * 256 + slot] = b * SEQ + sidx;
                gatev[pm * 256 + slot] = __builtin_bit_cast(float, v[i]);
                rsg[pm * 256 + slot] = rstd2[b * SEQ + sidx] * (EXP_FP8 ? W8_INV : 1.0f);
                inv[(size_t)(b * SEQ + sidx) * 16 + e] = slot;
            }
            base += __builtin_popcountll(ms); eqbase += __builtin_popcountll(meq);
        }
        __syncthreads();
    }
}

__device__ __forceinline__ void p7_final(Frame& F) {
    const bf16_t* CN = (const bf16_t*)(F.ws + WS_CN); const int* inv = (const int*)(F.ws + WS_INV);
    const int gw = F.vcu * NWAVES + F.wave, NGW = F.G * NWAVES, lane = F.lane, j = lane & 15, grp = lane >> 4;
    const int per = (M / 4 + NGW - 1) / NGW;
    for (int qd = gw * per; qd < (gw + 1) * per && qd < M / 4; ++qd) {
        const int tok = qd * 4 + grp, b = tok / SEQ;
        float* xr = F.out + (size_t)tok * DM + 8 * j;
        const int myinv = inv[(size_t)tok * 16 + j];
        f32x4 v[8][2];
        { const bf16_t* x1r = (const bf16_t*)(F.ws + WS_X1) + (size_t)tok * DM + 8 * j; u32x4 xw[8];
#pragma unroll
          for (int i = 0; i < 8; ++i) xw[i] = *(const u32x4*)(x1r + 128 * i);
          __builtin_amdgcn_sched_barrier(0);
#pragma unroll
          for (int i = 0; i < 8; ++i) { v[i][0] = (f32x4){bf_lo(xw[i].x), bf_hi(xw[i].x), bf_lo(xw[i].y), bf_hi(xw[i].y)}; v[i][1] = (f32x4){bf_lo(xw[i].z), bf_hi(xw[i].z), bf_lo(xw[i].w), bf_hi(xw[i].w)}; } }
        unsigned m16 = (unsigned)((__ballot(myinv >= 0) >> (16 * grp)) & 0xffffull);
        while (__any(m16 != 0u)) {
            const bool h0 = m16 != 0u; const int e0 = h0 ? __builtin_ctz(m16) : 0; m16 &= m16 - 1u;
            const int s0 = __shfl(myinv, 16 * grp + e0);
            if (h0) {
                if (EXP_FP8) {
                    const unsigned char* r0 = (const unsigned char*)CN + ((size_t)(e0 * 8 + b) * 256 + s0) * DM + 8 * j;
                    u32x2 w0[8];
#pragma unroll
                    for (int i = 0; i < 8; ++i) w0[i] = *(const u32x2*)(r0 + 128 * i);
                    __builtin_amdgcn_sched_barrier(0);
#pragma unroll
                    for (int i = 0; i < 8; ++i) {
                        const f32x2 a0 = __builtin_amdgcn_cvt_pk_f32_fp8((int)w0[i].x, false), a1 = __builtin_amdgcn_cvt_pk_f32_fp8((int)w0[i].x, true);
                        const f32x2 b0 = __builtin_amdgcn_cvt_pk_f32_fp8((int)w0[i].y, false), b1 = __builtin_amdgcn_cvt_pk_f32_fp8((int)w0[i].y, true);
                        v[i][0].x += a0.x * CN_INV; v[i][0].y += a0.y * CN_INV; v[i][0].z += a1.x * CN_INV; v[i][0].w += a1.y * CN_INV;
                        v[i][1].x += b0.x * CN_INV; v[i][1].y += b0.y * CN_INV; v[i][1].z += b1.x * CN_INV; v[i][1].w += b1.y * CN_INV; }
                } else {
                    const bf16_t* r0 = CN + ((size_t)(e0 * 8 + b) * 256 + s0) * DM + 8 * j;
                    u32x4 w0[8];
#pragma unroll
                    for (int i = 0; i < 8; ++i) w0[i] = *(const u32x4*)(r0 + 128 * i);
                    __builtin_amdgcn_sched_barrier(0);
#pragma unroll
                    for (int i = 0; i < 8; ++i) { v[i][0].x += bf_lo(w0[i].x); v[i][0].y += bf_hi(w0[i].x); v[i][0].z += bf_lo(w0[i].y); v[i][0].w += bf_hi(w0[i].y);
                        v[i][1].x += bf_lo(w0[i].z); v[i][1].y += bf_hi(w0[i].z); v[i][1].z += bf_lo(w0[i].w); v[i][1].w += bf_hi(w0[i].w); }
                }
            }
        }
        float ss = 0.f;
#pragma unroll
        for (int i = 0; i < 8; ++i)
#pragma unroll
            for (int c = 0; c < 2; ++c) ss += (v[i][c].x * v[i][c].x + v[i][c].y * v[i][c].y) + (v[i][c].z * v[i][c].z + v[i][c].w * v[i][c].w);
        ss += __shfl_xor(ss, 1); ss += __shfl_xor(ss, 2); ss += __shfl_xor(ss, 4); ss += __shfl_xor(ss, 8);
        const float rstd = 1.0f / sqrtf(ss * (1.f / DM) + RMS_EPS);
        int zo = 0; asm volatile("" : "+v"(zo));
        f32x4 gq[8][2];
#pragma unroll
        for (int i = 0; i < 8; ++i) { gq[i][0] = *(const f32x4*)(F.g_final + zo + 8 * j + 128 * i); gq[i][1] = *(const f32x4*)(F.g_final + zo + 8 * j + 128 * i + 4); }
        __builtin_amdgcn_sched_barrier(0);
#pragma unroll
        for (int i = 0; i < 8; ++i) { *(f32x4*)(xr + 128 * i) = v[i][0] * rstd * gq[i][0]; *(f32x4*)(xr + 128 * i + 4) = v[i][1] * rstd * gq[i][1]; }
    }
}

struct Args { const void* in[14]; float* out; unsigned char* ws; int ph_lo, ph_hi; };
__global__ void __launch_bounds__(NTHREADS, 2) fwd_kernel(Args args) {
    extern __shared__ __attribute__((aligned(16))) unsigned char lds[];
    Frame F;
    F.lds = (LAS unsigned char*)lds;
    F.tid = threadIdx.x; F.lane = F.tid & 63; F.wave = __builtin_amdgcn_readfirstlane(F.tid >> 6);
    F.G = gridDim.x; { const int bx = blockIdx.x; F.vcu = (F.G % 8 == 0) ? (bx % 8) * (F.G / 8) + bx / 8 : bx; }
    F.x = (const float*)args.in[0]; F.pos = (const int*)args.in[1]; F.g_mix = (const float*)args.in[2]; F.w_in = (const float*)args.in[3];
    F.conv_w = (const float*)args.in[4]; F.g_conv = (const float*)args.in[5]; F.g_attn = (const float*)args.in[6]; F.w_out = (const float*)args.in[7];
    F.g_ffn = (const float*)args.in[8]; F.w_router = (const float*)args.in[9]; F.w_gate = (const float*)args.in[10]; F.w_up = (const float*)args.in[11];
    F.w_down = (const float*)args.in[12]; F.g_final = (const float*)args.in[13];
    F.out = args.out; F.ws = args.ws;
    volatile LAS unsigned* MISC = (volatile LAS unsigned*)(F.lds + MISC_OFF);
    for (int u = F.tid; u < (LDS_BYTES - LDSCTL_OFF) / 4; u += NTHREADS) ((LAS unsigned*)(F.lds + LDSCTL_OFF))[u] = 0u;
    __syncthreads();
    const int lo = args.ph_lo, hi = args.ph_hi;
    XcdBarrier bar; bar.bar = (unsigned*)(F.ws + WS_CTL) + CW_BAR; bar.x = 0; bar.st = nullptr;
    if (hi - lo > 1) bar = xcd_barrier_post((unsigned*)(F.ws + WS_CTL) + CW_BAR, MISC + 8);
#ifndef PH_MASK
#define PH_MASK 0x3ff
#endif
#define IN(k) (((PH_MASK >> (k)) & 1) && lo <= (k) && (k) < hi)
#define SEAM(k) do { if (IN(k) && IN((k) + 1)) xcd_barrier(bar); } while (0)
    bf16_t* XN = (bf16_t*)(F.ws + WS_XN);
    if (IN(0)) { p0_prologue(F); SEAM(0); }
    if (IN(1)) {
        const bool split = OVERLAP_CONV && NG1 > 0 && F.G == 256;
        if (split && NG1 == 192 && (int)blockIdx.x < NG1) {
            Gemm g{XN, (const bf16_t*)(F.ws + WS_WIN), nullptr, DM}; Gemm1Order S; S.init((int)blockIdx.x);
            EpiQKV E{(bf16_t*)(F.ws + WS_PB), (bf16_t*)(F.ws + WS_QH), (const float*)(F.ws + WS_ROPE)};
            gemm_phase_fast<false>(F.lds, g, S, E);
        } else
        if (!split || (int)blockIdx.x < NG1) {
            Gemm g{XN, (const bf16_t*)(F.ws + WS_WIN), nullptr, DM}; DenseOrder S; S.init(M, PW, split ? NG1 : F.G, (int)blockIdx.x);
            EpiQKV E{(bf16_t*)(F.ws + WS_PB), (bf16_t*)(F.ws + WS_QH), (const float*)(F.ws + WS_ROPE)};
            gemm_phase_fast<false>(F.lds, g, S, E);
        } else {
            convert_items(F, I_IN, I_IN + N1_ITEMS, F.lds + F.wave * 16384, 0, 1 << 20, ((int)blockIdx.x - NG1) * NWAVES + F.wave, (F.G - NG1) * NWAVES);
        }
        SEAM(1);
    }
    if (IN(2)) {
        if (OVERLAP_CONV) {
            const int c0 = I_IN + ((NG1 > 0 && F.G == 256) ? N1_ITEMS : 0);
            if (F.wave < ATT_WAVES) p2a_attention_w<ATT_WAVES>(F);
            else convert_items(F, c0, NITEMS - ((F.G == 256) ? N5_ITEMS + N6_ITEMS : 0), F.lds + F.wave * 16384, 0, 1 << 20, F.vcu * (NWAVES - ATT_WAVES) + (F.wave - ATT_WAVES), F.G * (NWAVES - ATT_WAVES));
        } else p2a_attention(F);
        SEAM(2); }
    if (IN(3)) { p2b_combine(F); SEAM(3); }
    if (IN(4)) {
        Gemm g{(const bf16_t*)(F.ws + WS_Y), (const bf16_t*)(F.ws + WS_WOUT), nullptr, DM}; DenseOrder S; S.init(M, DM, F.G, (int)blockIdx.x);
        EpiRes E{XN, (const float*)(F.ws + WS_IRSTD1), (bf16_t*)(F.ws + WS_X1), (bf16_t*)(F.ws + WS_XN2)};
        gemm_phase_fast<false>(F.lds, g, S, E); SEAM(4);
    }
    if (IN(5)) {
        p3b_router(F); SEAM(5); }
    if (IN(6)) {
        if (OVERLAP_CONV && F.G == 256 && F.vcu >= BATCH * NE)
            convert_items(F, NITEMS - N6_ITEMS, NITEMS, F.lds + F.wave * 16384, 0, 1 << 20, (F.vcu - BATCH * NE) * NWAVES + F.wave, (F.G - BATCH * NE) * NWAVES);
        p4_topk(F); SEAM(6); }
    if (IN(7)) {
        Gemm g{(const bf16_t*)(F.ws + WS_XN2), (const bf16_t*)(F.ws + WS_WGU), (const int*)(F.ws + WS_AROWS), EXP_FP8 ? DM / 2 : DM}; ExpertOrder S; S.init(16, F.G, (int)blockIdx.x);
        EpiSwiGLU E{(bf16_t*)(F.ws + WS_H), (const float*)(F.ws + WS_RSG)};
        { LAS int* al = (LAS int*)(F.lds + AROWS_LDS_OFF); Unit uu;
          for (int i = 0; i < 8 && S.next(i, uu); ++i) if (F.tid < 256) al[i * 256 + F.tid] = g.arows[uu.pm * 256 + F.tid];
          __syncthreads(); g.arows_l = al; }
        gemm_phase_fast<EXP_FP8 != 0>(F.lds, g, S, E); SEAM(7);
    }
    if (IN(8)) {
        Gemm g{(const bf16_t*)(F.ws + WS_H), (const bf16_t*)(F.ws + WS_WD), nullptr, EXP_FP8 ? DFF / 2 : DFF}; ExpertOrder S; S.init(4, F.G, (int)blockIdx.x);
        EpiContrib E{(bf16_t*)(F.ws + WS_CN), (const float*)(F.ws + WS_GATEV)};
        gemm_phase_fast<EXP_FP8 != 0>(F.lds, g, S, E); SEAM(8);
    }
    if (IN(9)) { p7_final(F); }
#undef IN
#undef SEAM
}

extern "C" void kernel_launch(void* const* d_in, const int* in_sizes, int n_in, void* d_out, int out_size, void* d_ws, size_t ws_size, hipStream_t stream) {
    static int grid = 0;
    if (grid == 0) {
        if (n_in != 14 || out_size != M * DM || ws_size < WS_END) { fprintf(stderr, "kernel_launch: unexpected problem (n_in %d out %d ws %zu)\n", n_in, out_size, ws_size); grid = -1; return; }
        int dev = 0, cus = 0, per_cu = 0;
        if (hipGetDevice(&dev) != hipSuccess || hipDeviceGetAttribute(&cus, hipDeviceAttributeMultiprocessorCount, dev) != hipSuccess) { grid = -1; return; }
        if (hipFuncSetAttribute((const void*)fwd_kernel, hipFuncAttributeMaxDynamicSharedMemorySize, LDS_BYTES) != hipSuccess) { fprintf(stderr, "kernel_launch: hipFuncSetAttribute failed\n"); grid = -1; return; }
        if (hipOccupancyMaxActiveBlocksPerMultiprocessor(&per_cu, (const void*)fwd_kernel, NTHREADS, LDS_BYTES) != hipSuccess || per_cu < 1) { fprintf(stderr, "kernel_launch: occupancy query says %d\n", per_cu); per_cu = 1; }
        (void)hipGetLastError();
        grid = cus;
    }
    if (grid < 0) return;
    (void)hipMemsetAsync((char*)d_ws + WS_CTL, 0, CTL_ZERO_BYTES, stream);
    Args a{};
    for (int i = 0; i < 14; ++i) a.in[i] = d_in[i];
    a.out = (float*)d_out; a.ws = (unsigned char*)d_ws;
    if (MK_N_LAUNCHES == 1) {
        a.ph_lo = 0; a.ph_hi = N_PHASES;
        hipLaunchKernelGGL(fwd_kernel, dim3(grid), dim3(NTHREADS), LDS_BYTES, stream, a);
    } else {
        for (int p = 0; p < N_PHASES; ++p) { a.ph_lo = p; a.ph_hi = p + 1; hipLaunchKernelGGL(fwd_kernel, dim3(grid), dim3(NTHREADS), LDS_BYTES, stream, a); }
    }
}
```
